# Optimizing an MI355X kernel written in HIP

```python
import jax, jax.numpy as jnp
from jax import lax
import numpy as np

D_MODEL = 1024
BATCH = 8
SEQ = 4096
DEPTH = 1

D_PLE = 256
D_RNN = 1024
RNN_BLOCKS = 8
RNN_BW = D_RNN // RNN_BLOCKS
RNN_CONV = 4
LRU_C = 8.0
D_CONV = 1024
SHORT_CONV = 3
N_BRANCH = 2
D_FF = 3 * D_MODEL
FFN_CONV = 3
D_IN = 2 * D_RNN + 3 * D_CONV + N_BRANCH * D_MODEL
EPS = 1e-6

kernel_name = "hybrid_rglru_shortconv_block"


def rmsnorm(u, g):
    uf = u.astype(jnp.float32)
    y = uf * lax.rsqrt(jnp.mean(uf * uf, axis=-1, keepdims=True) + EPS)
    return (y * g.astype(jnp.float32)).astype(u.dtype)


def causal_dwconv(u, w):
    K = w.shape[0]
    S = u.shape[1]
    up = jnp.pad(u, ((0, 0), (K - 1, 0), (0, 0)))
    y = up[:, 0:S] * w[0]
    for k in range(1, K):
        y = y + up[:, k:k + S] * w[k]
    return y


def rg_lru(xc, w_a, b_a, w_x, b_x, lam):
    Bn, S, _ = xc.shape
    xb = xc.reshape(Bn, S, RNN_BLOCKS, RNN_BW)
    r = jax.nn.sigmoid((jnp.einsum('bshi,hij->bshj', xb, w_a).reshape(Bn, S, D_RNN) + b_a).astype(jnp.float32))
    i = jax.nn.sigmoid((jnp.einsum('bshi,hij->bshj', xb, w_x).reshape(Bn, S, D_RNN) + b_x).astype(jnp.float32))
    log_a = -LRU_C * r * jax.nn.softplus(-lam.astype(jnp.float32))
    a = jnp.exp(log_a)
    mult = jnp.sqrt(-jnp.expm1(2.0 * log_a))
    b = mult * (i * xc.astype(jnp.float32))

    def combine(lhs, rhs):
        a1, b1 = lhs
        a2, b2 = rhs
        return a1 * a2, a2 * b1 + b2

    _, h = lax.associative_scan(combine, (a, b), axis=1)
    return h.astype(xc.dtype)


def setup_inputs(seed: int = 0) -> dict:
    key = jax.random.key(seed)
    ks = jax.random.split(key, 24)
    f32 = jnp.float32

    def nrm(k, shape, scale):
        return jax.random.normal(k, shape, f32) * scale

    u = jax.random.uniform(ks[10], (DEPTH, D_RNN), f32, 0.9, 0.999)
    a0 = u ** (1.0 / LRU_C)
    lru_lambda = jnp.log(a0) - jnp.log1p(-a0)
    return {
        "x": nrm(ks[0], (BATCH, SEQ, D_MODEL), 1.0),
        "p": nrm(ks[1], (DEPTH, BATCH, SEQ, D_PLE), 1.0),
        "g_mix": 1.0 + nrm(ks[2], (DEPTH, D_MODEL), 0.02),
        "w_in": nrm(ks[3], (DEPTH, D_MODEL, D_IN), D_MODEL ** -0.5),
        "rnn_conv_w": nrm(ks[4], (DEPTH, RNN_CONV, D_RNN), RNN_CONV ** -0.5),
        "rnn_conv_b": nrm(ks[5], (DEPTH, D_RNN), 0.01),
        "w_rg_a": nrm(ks[6], (DEPTH, RNN_BLOCKS, RNN_BW, RNN_BW), RNN_BW ** -0.5),
        "b_rg_a": nrm(ks[7], (DEPTH, D_RNN), 0.01),
        "w_rg_x": nrm(ks[8], (DEPTH, RNN_BLOCKS, RNN_BW, RNN_BW), RNN_BW ** -0.5),
        "b_rg_x": nrm(ks[9], (DEPTH, D_RNN), 0.01),
        "lru_lambda": lru_lambda,
        "sc_conv_w": nrm(ks[11], (DEPTH, SHORT_CONV, D_CONV), SHORT_CONV ** -0.5),
        "w_proj_a": nrm(ks[12], (DEPTH, D_RNN, D_MODEL), D_RNN ** -0.5),
        "w_proj_b": nrm(ks[13], (DEPTH, D_CONV, D_MODEL), D_CONV ** -0.5),
        "w_out": nrm(ks[14], (DEPTH, D_MODEL, D_MODEL), D_MODEL ** -0.5),
        "g_ffn": 1.0 + nrm(ks[15], (DEPTH, D_MODEL), 0.02),
        "w_up": nrm(ks[16], (DEPTH, D_MODEL, 2 * D_FF), D_MODEL ** -0.5),
        "ffn_conv_w": nrm(ks[17], (DEPTH, FFN_CONV, 2 * D_FF), FFN_CONV ** -0.5),
        "ffn_conv_b": nrm(ks[18], (DEPTH, 2 * D_FF), 0.01),
        "w_down": nrm(ks[19], (DEPTH, D_FF, D_MODEL), D_FF ** -0.5),
        "w_ple_gate": nrm(ks[20], (DEPTH, D_MODEL, D_MODEL), D_MODEL ** -0.5),
        "w_ple_proj": nrm(ks[21], (DEPTH, D_PLE, D_MODEL), D_PLE ** -0.5),
        "g_ple": 1.0 + nrm(ks[22], (DEPTH, D_MODEL), 0.02),
        "g_final": 1.0 + nrm(ks[23], (D_MODEL,), 0.02),
    }


def reference(x, p, g_mix, w_in, rnn_conv_w, rnn_conv_b, w_rg_a, b_rg_a, w_rg_x, b_rg_x,
              lru_lambda, sc_conv_w, w_proj_a, w_proj_b, w_out, g_ffn, w_up, ffn_conv_w,
              ffn_conv_b, w_down, w_ple_gate, w_ple_proj, g_ple, g_final):
    split_idx = (D_RNN, 2 * D_RNN, 2 * D_RNN + D_CONV, 2 * D_RNN + 2 * D_CONV,
                 2 * D_RNN + 3 * D_CONV, 2 * D_RNN + 3 * D_CONV + D_MODEL)
    for l in range(DEPTH):
        h = rmsnorm(x, g_mix[l])
        z = h @ w_in[l]
        xr, gr, cb, cc, cx, ga, gb = jnp.split(z, split_idx, axis=-1)

        xr = causal_dwconv(xr, rnn_conv_w[l]) + rnn_conv_b[l]
        ya = rg_lru(xr, w_rg_a[l], b_rg_a[l], w_rg_x[l], b_rg_x[l], lru_lambda[l]) * jax.nn.gelu(gr)

        yb = cb * causal_dwconv(cc * cx, sc_conv_w[l])

        m = jax.nn.sigmoid(ga) * (ya @ w_proj_a[l]) + jax.nn.sigmoid(gb) * (yb @ w_proj_b[l])
        x = x + m @ w_out[l]

        h = rmsnorm(x, g_ffn[l])
        u = causal_dwconv(h @ w_up[l], ffn_conv_w[l]) + ffn_conv_b[l]
        ug, uv = jnp.split(u, 2, axis=-1)
        x = x + (jax.nn.gelu(ug) * uv) @ w_down[l]

        e = rmsnorm(p[l] @ w_ple_proj[l], g_ple[l])
        x = x + jax.nn.sigmoid(x @ w_ple_gate[l]) * e
    return rmsnorm(x, g_final)
```

```cpp
#include <hip/hip_runtime.h>
#include <hip/hip_cooperative_groups.h>
#include <cstdio>
#include <cstdint>
namespace cg = cooperative_groups;
namespace pg8 {
#define PG8_LAS __attribute__((address_space(3)))
typedef unsigned short bf16_t;
typedef short bf16x8 __attribute__((ext_vector_type(8)));
typedef float f32x4 __attribute__((ext_vector_type(4)));
typedef unsigned u32x4 __attribute__((ext_vector_type(4)));
constexpr int BM = 256, BK = 64, HALF = 128, HTB = HALF * BK * 2  , STAGE_BYTES = 8 * HTB, NXCD = 8, WGM = 2;

__host__ __device__ __forceinline__ int lds_byte(int r, int c) { const int st = (r >> 4) * 2 + (c >> 5), rr = r & 15, cc = c & 31, ob = rr * 64 + cc * 2; return st * 1024 + (ob ^ (((ob >> 9) & 1) << 5)); }
__host__ __device__ __forceinline__ void stage_rc(int b, int& R, int& C) { const int st = b / 1024, sb = b % 1024, swz = sb ^ (((sb >> 9) & 1) << 5); R = (st >> 1) * 16 + swz / 64; C = (st & 1) * 32 + (swz % 64) / 2; }
__host__ __device__ __forceinline__ int perm32(int rho) { const int n = rho >> 4, i = rho & 15; return 8 * (i >> 2) + 4 * n + (i & 3); }

struct Unit { int pm, pn, seg; };
struct Gemm { const bf16_t* A; const bf16_t* Bt; int M, N, K; const bf16_t* A2; const bf16_t* Bt2; };

struct StaticOrder {
    int nM, nN, nwg, G, c;
    __host__ __device__ void init(int M, int N, int G_, int c_) { nM = M / BM; nN = N / BM; nwg = nM * nN; G = G_; c = c_; }
    __host__ __device__ bool next(int i, Unit& u) const {
        const long L = (long)i * G + c; if (L >= nwg) return false;
        int wgid = (int)L; { const int q = nwg / NXCD, r = nwg % NXCD, xcd = wgid % NXCD, off = wgid / NXCD; wgid = (xcd < r ? xcd * (q + 1) : r * (q + 1) + (xcd - r) * q) + off; }
        const int nig = WGM * nN, gid = wgid / nig, fm = gid * WGM, gsz = (nM - fm) < WGM ? (nM - fm) : WGM;
        u.pm = fm + ((wgid % nig) % gsz); u.pn = (wgid % nig) / gsz; u.seg = 0; return true;
    }
    __device__ __forceinline__ void a_ready(const Unit&) const {}
    __device__ __forceinline__ void done(const Unit&) const {}
};
struct StaticOrder2 : StaticOrder {
    __host__ __device__ bool next(int i, Unit& u) const { if (!StaticOrder::next(i >> 1, u)) return false; u.seg = i & 1; return true; }
};


__device__ __forceinline__ unsigned cvt_pk_bf16(float lo, float hi) { unsigned r; asm volatile("v_cvt_pk_bf16_f32 %0, %1, %2" : "=v"(r) : "v"(lo), "v"(hi)); return r; }
template <class Epi, class Sched, bool ALIGN_EPI = false, bool SP2 = false>
__device__ __forceinline__ void gemm_phase(PG8_LAS unsigned char* lds, const Gemm g, const Sched& S, const Epi& E) {
    int tid = threadIdx.x; asm volatile("" : "+v"(tid)); const int wid = __builtin_amdgcn_readfirstlane(tid >> 6), lane = tid & 63, wr = wid >> 2, wc = wid & 3, fr = lane & 15, fq = lane >> 4;
    const int K = g.K, nt = K / BK;
    unsigned voffA[2], voffB[2];
#pragma unroll
    for (int i = 0; i < 2; ++i) { int R, C; stage_rc(tid * 16 + i * 8192, R, C); const int Rb = Epi::PERM ? ((R & ~31) + perm32(R & 31)) : R;
        voffA[i] = (unsigned)(R * K + C) * 2u; voffB[i] = (unsigned)(Rb * K + C) * 2u; }
    const size_t kstep = (size_t)(BK * 2);
    const size_t hstep = (size_t)HALF * K * 2;
    const size_t tstep = 2 * hstep;
    const unsigned ldsw = (unsigned)wid * 1024u;
    const int aoff = lds_byte(wr * 64 + fr, fq * 8), boff = lds_byte(wc * 32 + fr, fq * 8);
#define PG8_SA(b, h) (((b) * 2 + (h)) * HTB)
#define PG8_SB(b, h) ((4 + (b) * 2 + (h)) * HTB)
#define PG8_STAGE(bufoff, gbase, voff) do { _Pragma("unroll") for (int _i = 0; _i < 2; ++_i) \
        __builtin_amdgcn_global_load_lds((const unsigned*)((const char*)(gbase) + (voff)[_i]), (PG8_LAS unsigned*)(lds + (bufoff) + ldsw + _i * 8192), 16, 0, 0); } while (0)
#define PG8_LDA(dst, b, h) do { _Pragma("unroll") for (int m = 0; m < 4; ++m) _Pragma("unroll") for (int k = 0; k < 2; ++k) dst[m][k] = *(const PG8_LAS bf16x8*)(lds + PG8_SA(b, h) + aoff + m * 2048 + k * 1024); } while (0)
#define PG8_LDB(dst, b, h) do { _Pragma("unroll") for (int n = 0; n < 2; ++n) _Pragma("unroll") for (int k = 0; k < 2; ++k) dst[n][k] = *(const PG8_LAS bf16x8*)(lds + PG8_SB(b, h) + boff + n * 2048 + k * 1024); } while (0)
#define PG8_MMA(ai, bj, At, Bt) do { __builtin_amdgcn_s_setprio(1); _Pragma("unroll") for (int m = 0; m < 4; ++m) _Pragma("unroll") for (int n = 0; n < 2; ++n) _Pragma("unroll") for (int k = 0; k < 2; ++k) \
        acc[ai][bj][m][n] = __builtin_amdgcn_mfma_f32_16x16x32_bf16(Bt[n][k], At[m][k], acc[ai][bj][m][n], 0, 0, 0); __builtin_amdgcn_s_setprio(0); } while (0)
#define PG8_WAIT_V(n) asm volatile("s_waitcnt vmcnt(" #n ")" ::: "memory")
#define PG8_WAIT_L(n) asm volatile("s_waitcnt lgkmcnt(" #n ")" ::: "memory")
#define PG8_BAR __builtin_amdgcn_s_barrier()
#define PG8_SCHED __builtin_amdgcn_sched_barrier(0)
    Unit cur, nxt; int ui = 0;
    if (!S.next(0, cur)) return;
    f32x4 acc[2][2][4][2];
#pragma unroll
    for (int a = 0; a < 2; ++a)
#pragma unroll
        for (int b = 0; b < 2; ++b)
#pragma unroll
            for (int m = 0; m < 4; ++m)
#pragma unroll
                for (int n = 0; n < 2; ++n) acc[a][b][m][n] = (f32x4){0.f, 0.f, 0.f, 0.f};
    bf16x8 At[4][2], B0[2][2], B1[2][2];
    const char* cA = (const char*)(cur.seg ? g.A2 : g.A) + (size_t)cur.pm * tstep; const char* cB = (const char*)(cur.seg ? g.Bt2 : g.Bt) + (size_t)cur.pn * tstep;
    S.a_ready(cur);
    if constexpr (SP2) {
        PG8_STAGE(PG8_SB(0, 0), cB, voffB); PG8_STAGE(PG8_SB(0, 1), cB + hstep, voffB); PG8_STAGE(PG8_SA(0, 0), cA, voffA); PG8_STAGE(PG8_SA(0, 1), cA + hstep, voffA);
        if (wr == 1) PG8_BAR;
        PG8_WAIT_V(2); PG8_BAR;
        PG8_STAGE(PG8_SB(1, 0), cB + kstep, voffB); PG8_STAGE(PG8_SA(1, 0), cA + kstep, voffA); PG8_STAGE(PG8_SB(1, 1), cB + hstep + kstep, voffB);
        PG8_WAIT_V(6); PG8_BAR;
    } else {
        PG8_STAGE(PG8_SB(0, 0), cB, voffB); PG8_STAGE(PG8_SA(0, 0), cA, voffA); PG8_STAGE(PG8_SB(0, 1), cB + hstep, voffB); PG8_STAGE(PG8_SA(0, 1), cA + hstep, voffA);
        if (wr == 1) PG8_BAR;
        PG8_WAIT_V(4); PG8_BAR;
        PG8_STAGE(PG8_SB(1, 0), cB + kstep, voffB); PG8_STAGE(PG8_SA(1, 0), cA + kstep, voffA); PG8_STAGE(PG8_SB(1, 1), cB + hstep + kstep, voffB);
        PG8_WAIT_V(6); PG8_BAR;
    }
    for (;;) {
        const bool has_next = S.next(ui + 1, nxt);
        const char* nA = has_next ? (const char*)(nxt.seg ? g.A2 : g.A) + (size_t)nxt.pm * tstep : cA; const char* nB = has_next ? (const char*)(nxt.seg ? g.Bt2 : g.Bt) + (size_t)nxt.pn * tstep : cB;
        for (int t = 0; t < nt; t += 2) {
            const bool last = (t == nt - 2);
            const char* a1 = cA + (size_t)(t + 1) * kstep;
            const char* a2 = last ? nA : cA + (size_t)(t + 2) * kstep; const char* b2 = last ? nB : cB + (size_t)(t + 2) * kstep;
            const char* a3 = a2 + kstep; const char* b3 = b2 + kstep;
            if (last && has_next) S.a_ready(nxt);
            if constexpr (SP2) {
            PG8_LDB(B0, 0, 0); PG8_LDB(B1, 0, 1); PG8_SCHED; PG8_LDA(At, 0, 0); PG8_STAGE(PG8_SA(1, 1), a1 + hstep, voffA);
            PG8_WAIT_V(8); PG8_WAIT_L(0); PG8_BAR; PG8_MMA(0, 0, At, B0); PG8_MMA(0, 1, At, B1); PG8_BAR; PG8_SCHED;
            PG8_LDA(At, 0, 1); PG8_STAGE(PG8_SB(0, 0), b2, voffB); PG8_STAGE(PG8_SB(0, 1), b2 + hstep, voffB); PG8_STAGE(PG8_SA(0, 0), a2, voffA);
            PG8_WAIT_V(8); PG8_WAIT_L(0); PG8_BAR; PG8_MMA(1, 0, At, B0); PG8_MMA(1, 1, At, B1); PG8_BAR; PG8_SCHED;
            PG8_LDB(B0, 1, 0); PG8_LDB(B1, 1, 1); PG8_SCHED; PG8_LDA(At, 1, 0); PG8_STAGE(PG8_SA(0, 1), a2 + hstep, voffA);
            PG8_WAIT_V(8); PG8_WAIT_L(0); PG8_BAR; PG8_MMA(0, 0, At, B0); PG8_MMA(0, 1, At, B1); PG8_BAR; PG8_SCHED;
            PG8_LDA(At, 1, 1); PG8_STAGE(PG8_SB(1, 0), b3, voffB); PG8_STAGE(PG8_SB(1, 1), b3 + hstep, voffB); PG8_STAGE(PG8_SA(1, 0), a3, voffA);
            PG8_WAIT_V(8); PG8_WAIT_L(0); PG8_BAR; PG8_MMA(1, 0, At, B0); PG8_MMA(1, 1, At, B1); PG8_BAR; PG8_SCHED;
            } else {
            PG8_LDB(B0, 0, 0); PG8_SCHED; PG8_LDA(At, 0, 0); PG8_STAGE(PG8_SA(1, 1), a1 + hstep, voffA);
            PG8_WAIT_L(8); PG8_BAR; PG8_WAIT_L(0); PG8_MMA(0, 0, At, B0); PG8_BAR; PG8_SCHED;
            PG8_LDB(B1, 0, 1); PG8_STAGE(PG8_SB(0, 0), b2, voffB);
            PG8_BAR; PG8_WAIT_L(0); PG8_MMA(0, 1, At, B1); PG8_BAR;
            PG8_LDA(At, 0, 1); PG8_STAGE(PG8_SA(0, 0), a2, voffA);
            PG8_BAR; PG8_WAIT_L(0); PG8_MMA(1, 0, At, B0); PG8_BAR; PG8_SCHED;
            PG8_STAGE(PG8_SB(0, 1), b2 + hstep, voffB);
            PG8_WAIT_V(6); PG8_BAR; PG8_MMA(1, 1, At, B1); PG8_BAR;
            PG8_LDB(B0, 1, 0); PG8_SCHED; PG8_LDA(At, 1, 0); PG8_STAGE(PG8_SA(0, 1), a2 + hstep, voffA);
            PG8_WAIT_L(8); PG8_BAR; PG8_WAIT_L(0); PG8_MMA(0, 0, At, B0); PG8_BAR; PG8_SCHED;
            PG8_LDB(B1, 1, 1); PG8_STAGE(PG8_SB(1, 0), b3, voffB);
            PG8_BAR; PG8_WAIT_L(0); PG8_MMA(0, 1, At, B1); PG8_BAR;
            PG8_LDA(At, 1, 1); PG8_STAGE(PG8_SA(1, 0), a3, voffA);
            PG8_BAR; PG8_WAIT_L(0); PG8_MMA(1, 0, At, B0); PG8_BAR; PG8_SCHED;
            PG8_STAGE(PG8_SB(1, 1), b3 + hstep, voffB);
            PG8_WAIT_V(6); PG8_BAR; PG8_MMA(1, 1, At, B1); PG8_BAR;
            }
        }
        if constexpr (ALIGN_EPI) { if (wr == 0) PG8_BAR; }
        if constexpr (!Epi::AFTER_DRAIN) { E(acc, cur, wr, wc, fr, fq); S.done(cur); }
        if (!has_next) break;
        if (!Epi::TWOSEG || cur.seg != 0) {
#pragma unroll
        for (int a = 0; a < 2; ++a)
#pragma unroll
            for (int b = 0; b < 2; ++b)
#pragma unroll
                for (int m = 0; m < 4; ++m)
#pragma unroll
                    for (int n = 0; n < 2; ++n) acc[a][b][m][n] = (f32x4){0.f, 0.f, 0.f, 0.f};
        }
        cur = nxt; cA = nA; cB = nB; ++ui;
        if constexpr (ALIGN_EPI) { if (wr == 1) PG8_BAR; }
    }
    PG8_WAIT_V(0);
    if constexpr (!ALIGN_EPI) { if (wr == 0) PG8_BAR; }
    PG8_BAR;
    if constexpr (Epi::AFTER_DRAIN) { E.fused(acc, cur, wr, wc, fr, fq, lds, wid, lane); S.done(cur); }
#undef PG8_SA
#undef PG8_SB
#undef PG8_STAGE
#undef PG8_LDA
#undef PG8_LDB
#undef PG8_MMA
#undef PG8_WAIT_V
#undef PG8_WAIT_L
#undef PG8_BAR
#undef PG8_SCHED
}
}
#define GAS __attribute__((address_space(1)))
#define LAS __attribute__((address_space(3)))
typedef unsigned short bf16_t;
typedef short bf16x8 __attribute__((ext_vector_type(8)));
typedef float f32x4 __attribute__((ext_vector_type(4)));
typedef unsigned u32x4 __attribute__((ext_vector_type(4)));
typedef unsigned u32x2 __attribute__((ext_vector_type(2)));
using pg8::Unit;
using pg8::cvt_pk_bf16;

constexpr int T = 32768, SEQ = 4096, DM = 1024, DIN = 7168, DFF = 3072, DPLE = 256, TH = 16384;
constexpr float EPS = 1e-6f;
constexpr size_t MiB = 1u << 20;
constexpr size_t TS = (size_t)T * DM;
constexpr size_t WS_BAR = 512 * 1024;
constexpr size_t WS_RSTD1 = 0, WS_SS2P = 1 * MiB, WS_SS3P = 3 * MiB, WS_SS4P = 5 * MiB;
constexpr size_t WS_WIN = 7 * MiB, WS_WUP = 21 * MiB, WS_WDOWN = 33 * MiB, WS_WPA = 39 * MiB, WS_WPB = 41 * MiB, WS_WOUT = 43 * MiB, WS_WGATE = 45 * MiB;
constexpr size_t WS_WPLE = 47 * MiB, WS_WRG = 47 * MiB + 512 * 1024;
constexpr size_t WS_XB = 48 * MiB, WS_BIG = 112 * MiB, WS_PB = 496 * MiB, WS_END = 512 * MiB;
constexpr int LDS_BYTES = 147456;
constexpr int NTHREADS = 512;
#ifndef PROBE_ID
#define PROBE_ID 0
#endif

struct Params {
    const float *x, *p, *g_mix, *w_in, *rnn_conv_w, *rnn_conv_b, *w_rg_a, *b_rg_a, *w_rg_x, *b_rg_x, *lru_lambda, *sc_conv_w, *w_proj_a, *w_proj_b, *w_out, *g_ffn,
        *w_up, *ffn_conv_w, *ffn_conv_b, *w_down, *w_ple_gate, *w_ple_proj, *g_ple, *g_final;
    float* out; unsigned char* ws;
};

__device__ __forceinline__ float bf_lo(unsigned w) { return __uint_as_float(w << 16); }
__device__ __forceinline__ float bf_hi(unsigned w) { return __uint_as_float(w & 0xffff0000u); }
__device__ __forceinline__ float bf2f(bf16_t b) { return __uint_as_float(((unsigned)b) << 16); }
__device__ __forceinline__ bf16_t f2bf(float f) { return (bf16_t)(cvt_pk_bf16(f, 0.f) & 0xffffu); }
__device__ __forceinline__ float sigmoid_f(float x) { return __builtin_amdgcn_rcpf(1.f + __builtin_amdgcn_exp2f(-1.4426950408889634f * x)); }
__device__ __forceinline__ float gelu_f(float x) { const float u = x * (1.f + 0.044715f * x * x); return x * __builtin_amdgcn_rcpf(1.f + __builtin_amdgcn_exp2f(-2.302208198f * u)); }
__device__ __forceinline__ u32x4 pack8(const f32x4 a, const f32x4 b) { u32x4 w; w.x = cvt_pk_bf16(a[0], a[1]); w.y = cvt_pk_bf16(a[2], a[3]); w.z = cvt_pk_bf16(b[0], b[1]); w.w = cvt_pk_bf16(b[2], b[3]); return w; }
__device__ __forceinline__ void unpack8(const u32x4 w, f32x4& a, f32x4& b) { a = (f32x4){bf_lo(w.x), bf_hi(w.x), bf_lo(w.y), bf_hi(w.y)}; b = (f32x4){bf_lo(w.z), bf_hi(w.z), bf_lo(w.w), bf_hi(w.w)}; }
__device__ __forceinline__ float wave_sum(float v) {
#pragma unroll
    for (int o = 1; o < 64; o <<= 1) v += __shfl_xor(v, o);
    return v;
}
__device__ __forceinline__ float sum16(const float* p) { const f32x4 a = *(const f32x4*)p, b = *(const f32x4*)(p + 4), c = *(const f32x4*)(p + 8), d = *(const f32x4*)(p + 12);
    return ((a[0] + a[1]) + (a[2] + a[3])) + ((b[0] + b[1]) + (b[2] + b[3])) + ((c[0] + c[1]) + (c[2] + c[3])) + ((d[0] + d[1]) + (d[2] + d[3])); }
__device__ __forceinline__ float rstd_from_parts(const float* ssp, int row) { return __builtin_amdgcn_rsqf(sum16(ssp + (size_t)row * 16) * (1.f / DM) + EPS); }

typedef f32x4 AccT[2][2][4][2];

struct EpiZ {
    static constexpr bool PERM = true, AFTER_DRAIN = false, TWOSEG = false;
    bf16_t* big;
    __device__ __forceinline__ void operator()(const AccT& acc, const Unit& u, int wr, int wc, int fr, int fq) const {
        const int pn = u.pn, row0 = u.pm * 256 + wr * 64 + fr;
        if (pn >= 12 && pn < 20) {
            bf16_t* O = big + 3 * TS + (pn - 12) * 128 + wc * 32 + 8 * fq;
#pragma unroll
            for (int ai = 0; ai < 2; ++ai)
#pragma unroll
                for (int m = 0; m < 4; ++m) { const int row = row0 + ai * 128 + m * 16;
                    const f32x4 v0 = acc[ai][0][m][0] * acc[ai][1][m][0], v1 = acc[ai][0][m][1] * acc[ai][1][m][1];
                    *(u32x4*)(O + (size_t)row * DM) = pack8(v0, v1); }
        } else {
            int tsel, cb, act;
            if (pn < 12) { tsel = pn >> 2; cb = (pn & 3) * 256; act = (tsel == 1) ? 1 : 0; } else { tsel = 4 + ((pn - 20) >> 2); cb = ((pn - 20) & 3) * 256; act = 2; }
            bf16_t* O = big + (size_t)tsel * TS + cb + wc * 32 + 8 * fq;
#pragma unroll
            for (int ai = 0; ai < 2; ++ai)
#pragma unroll
                for (int m = 0; m < 4; ++m) { const int row = row0 + ai * 128 + m * 16;
#pragma unroll
                    for (int bj = 0; bj < 2; ++bj) { f32x4 v0 = acc[ai][bj][m][0], v1 = acc[ai][bj][m][1];
                        if (act == 1) {
#pragma unroll
                            for (int j = 0; j < 4; ++j) { v0[j] = gelu_f(v0[j]); v1[j] = gelu_f(v1[j]); } }
                        else if (act == 2) {
#pragma unroll
                            for (int j = 0; j < 4; ++j) { v0[j] = sigmoid_f(v0[j]); v1[j] = sigmoid_f(v1[j]); } }
                        *(u32x4*)(O + (size_t)row * DM + bj * 128) = pack8(v0, v1); } }
        }
    }
};
struct EpiMerge {
    static constexpr bool PERM = true, AFTER_DRAIN = false, TWOSEG = true;
    const bf16_t* GA; const bf16_t* GB; bf16_t* O;
    __device__ __forceinline__ void operator()(AccT& acc, const Unit& u, int wr, int wc, int fr, int fq) const {
        const int row0 = u.pm * 256 + wr * 64 + fr, col0 = u.pn * 256 + wc * 32 + 8 * fq;
        if (u.seg == 0) {
#pragma unroll
            for (int ai = 0; ai < 2; ++ai)
#pragma unroll
                for (int m = 0; m < 4; ++m) { const size_t off = (size_t)(row0 + ai * 128 + m * 16) * DM + col0;
#pragma unroll
                    for (int bj = 0; bj < 2; ++bj) { f32x4 a0, a1, b0, b1; unpack8(*(const u32x4*)(GA + off + bj * 128), a0, a1); unpack8(*(const u32x4*)(GB + off + bj * 128), b0, b1);
#pragma unroll
                        for (int j = 0; j < 4; ++j) { acc[ai][bj][m][0][j] *= a0[j] * __builtin_amdgcn_rcpf(fmaxf(b0[j], 1e-20f)); acc[ai][bj][m][1][j] *= a1[j] * __builtin_amdgcn_rcpf(fmaxf(b1[j], 1e-20f)); } } }
        } else {
#pragma unroll
            for (int ai = 0; ai < 2; ++ai)
#pragma unroll
                for (int m = 0; m < 4; ++m) { const size_t off = (size_t)(row0 + ai * 128 + m * 16) * DM + col0;
#pragma unroll
                    for (int bj = 0; bj < 2; ++bj) { f32x4 b0, b1; unpack8(*(const u32x4*)(GB + off + bj * 128), b0, b1);
                        *(u32x4*)(O + off + bj * 128) = pack8(acc[ai][bj][m][0] * b0, acc[ai][bj][m][1] * b1); } }
        }
    }
};
template <bool SS, bool SCALE> struct EpiResB {
    static constexpr bool PERM = true, AFTER_DRAIN = false, TWOSEG = false;
    const bf16_t* R; const float* rscale; bf16_t* O; float* ssp;
    __device__ __forceinline__ void operator()(const AccT& acc, const Unit& u, int wr, int wc, int fr, int fq) const {
        const int row0 = u.pm * 256 + wr * 64 + fr, col0 = u.pn * 256 + wc * 32 + 8 * fq;
#pragma unroll
        for (int ai = 0; ai < 2; ++ai)
#pragma unroll
            for (int m = 0; m < 4; ++m) { const int row = row0 + ai * 128 + m * 16; const size_t off = (size_t)row * DM + col0; float ss = 0.f; const float sc = SCALE ? rscale[row] : 1.f;
#pragma unroll
                for (int bj = 0; bj < 2; ++bj) { f32x4 r0, r1; unpack8(*(const u32x4*)(R + off + bj * 128), r0, r1);
                    const f32x4 v0 = r0 * sc + acc[ai][bj][m][0], v1 = r1 * sc + acc[ai][bj][m][1];
                    *(u32x4*)(O + off + bj * 128) = pack8(v0, v1);
                    if (SS) ss += ((v0[0] * v0[0] + v0[1] * v0[1]) + (v0[2] * v0[2] + v0[3] * v0[3])) + ((v1[0] * v1[0] + v1[1] * v1[1]) + (v1[2] * v1[2] + v1[3] * v1[3])); }
                if (SS) { ss += __shfl_xor(ss, 16); ss += __shfl_xor(ss, 32); if (fq == 0) ssp[(size_t)row * 16 + u.pn * 4 + wc] = ss; } }
    }
};
#define DPP_F(v, ctrl) __int_as_float(__builtin_amdgcn_update_dpp(0, __float_as_int(v), (ctrl), 0xf, 0xf, true))
struct EpiAct {
    static constexpr bool PERM = true, AFTER_DRAIN = false, TWOSEG = false;
    bf16_t* ACT; const float* ssp; const float* cw; const float* cb; float* halo; LAS float* ex;
    __device__ __forceinline__ void operator()(AccT& acc, const Unit& u, int wr, int wc, int fr, int fq) const {
        const int row0 = u.pm * 256 + wr * 64 + fr, colA = u.pn * 128 + wc * 32 + 8 * fq, lc = wc * 32 + 8 * fq;
        LAS float* rsd = ex + 2048; LAS float* wts = ex + 2048 + 256;
        {
            const int t = (wr * 4 + wc) * 64 + fq * 16 + fr;
            if (t < 256) { const int bj = t >> 7, k = (t >> 5) & 3, c4 = (t & 31) * 4;
                const f32x4 v = (k < 3) ? *(const f32x4*)(cw + k * 2 * DFF + bj * DFF + u.pn * 128 + c4) : *(const f32x4*)(cb + bj * DFF + u.pn * 128 + c4);
                *(LAS f32x4*)(wts + (bj * 4 + k) * 128 + c4) = v; }
            else rsd[t - 256] = rstd_from_parts(ssp, u.pm * 256 + (t - 256));
        }
        asm volatile("s_waitcnt lgkmcnt(0)" ::: "memory"); __builtin_amdgcn_s_barrier(); asm volatile("" ::: "memory");
#pragma unroll
        for (int ai = 0; ai < 2; ++ai)
#pragma unroll
            for (int m = 0; m < 4; ++m) { const float rs = rsd[ai * 128 + wr * 64 + m * 16 + fr];
#pragma unroll
                for (int bj = 0; bj < 2; ++bj) { acc[ai][bj][m][0] *= rs; acc[ai][bj][m][1] *= rs; } }
        const int wv = wr * 4 + wc;
        if (fr >= 14) {
#pragma unroll
            for (int ai = 0; ai < 2; ++ai) { LAS float* e = ex + ((((wv * 2 + ai) * 2 + (fr - 14)) * 4 + fq) * 16);
#pragma unroll
                for (int bj = 0; bj < 2; ++bj) { *(LAS f32x4*)(e + bj * 8) = acc[ai][bj][3][0]; *(LAS f32x4*)(e + bj * 8 + 4) = acc[ai][bj][3][1]; } }
            if (wr == 1) { float* h = halo + ((size_t)u.pm * 4 + 2 + (fr - 14)) * (2 * DFF) + u.pn * 256 + lc;
#pragma unroll
                for (int bj = 0; bj < 2; ++bj) { *(f32x4*)(h + bj * 128) = acc[1][bj][3][0]; *(f32x4*)(h + bj * 128 + 4) = acc[1][bj][3][1]; } }
        }
        if (wr == 0 && fr < 2) { float* h = halo + ((size_t)u.pm * 4 + fr) * (2 * DFF) + u.pn * 256 + lc;
#pragma unroll
            for (int bj = 0; bj < 2; ++bj) { *(f32x4*)(h + bj * 128) = acc[0][bj][0][0]; *(f32x4*)(h + bj * 128 + 4) = acc[0][bj][0][1]; } }
        asm volatile("s_waitcnt lgkmcnt(0)" ::: "memory"); __builtin_amdgcn_s_barrier(); asm volatile("" ::: "memory");
        float tok = 0.f;
#pragma unroll
        for (int ai = 0; ai < 2; ++ai) {
            f32x4 V[2][2];
            if (ai == 0 && wr == 0) {
#pragma unroll
                for (int bj = 0; bj < 2; ++bj) { V[bj][0] = (f32x4){0.f, 0.f, 0.f, 0.f}; V[bj][1] = V[bj][0]; }
            } else {
                const int sw = (wr == 1) ? wc : 4 + wc, sai = (wr == 1) ? ai : ai - 1;
                const LAS float* e = ex + ((((sw * 2 + sai) * 2 + (fr >= 14 ? fr - 14 : 0)) * 4 + fq) * 16);
#pragma unroll
                for (int bj = 0; bj < 2; ++bj) { V[bj][0] = *(const LAS f32x4*)(e + bj * 8); V[bj][1] = *(const LAS f32x4*)(e + bj * 8 + 4); }
            }
#pragma unroll
            for (int bj = 0; bj < 2; ++bj)
#pragma unroll
                for (int n = 0; n < 2; ++n) {
                    int wo = (bj * 4) * 128 + lc + 4 * n; asm volatile("" : "+v"(wo), "+v"(tok));
                    const f32x4 w0 = *(const LAS f32x4*)(wts + wo), w1 = *(const LAS f32x4*)(wts + wo + 128), w2 = *(const LAS f32x4*)(wts + wo + 256), bb = *(const LAS f32x4*)(wts + wo + 384);
                    const f32x4 zz = {0.f, 0.f, 0.f, 0.f};
                    const f32x4 w1z = (fr == 0) ? w1 : zz, w0z = (fr < 2) ? w0 : zz;
#pragma unroll
                    for (int m = 3; m >= 0; --m) {
                        if (m > 0) asm volatile("" : "+v"(tok), "+v"(acc[ai][bj][m][n]), "+v"(acc[ai][bj][m - 1][n])); else asm volatile("" : "+v"(tok), "+v"(acc[ai][bj][m][n]), "+v"(V[bj][n]));
                        const f32x4 cur = acc[ai][bj][m][n]; const f32x4 prv = (m > 0) ? acc[ai][bj][m - 1][n] : V[bj][n]; f32x4 o;
#pragma unroll
                        for (int j = 0; j < 4; ++j) o[j] = bb[j] + w2[j] * cur[j] + w1[j] * DPP_F(cur[j], 0x111) + w0[j] * DPP_F(cur[j], 0x112) + w1z[j] * DPP_F(prv[j], 0x121) + w0z[j] * DPP_F(prv[j], 0x122);
                        acc[ai][bj][m][n] = o; tok = o[3]; }
                }
#pragma unroll
            for (int m = 0; m < 4; ++m) { const int row = row0 + ai * 128 + m * 16; f32x4 a0, a1;
                asm volatile("" : "+v"(tok), "+v"(acc[ai][0][m][0]), "+v"(acc[ai][0][m][1]));
#pragma unroll
                for (int j = 0; j < 4; ++j) { a0[j] = gelu_f(acc[ai][0][m][0][j]) * acc[ai][1][m][0][j]; a1[j] = gelu_f(acc[ai][0][m][1][j]) * acc[ai][1][m][1][j]; }
                const u32x4 pk = pack8(a0, a1); tok = __uint_as_float(pk.x);
                *(u32x4*)(ACT + (size_t)row * DFF + colA) = pk; }
        }
    }
};
struct EpiE0 {
    static constexpr bool PERM = true, AFTER_DRAIN = false, TWOSEG = false;
    bf16_t* E0; float* ssp;
    __device__ __forceinline__ void operator()(const AccT& acc, const Unit& u, int wr, int wc, int fr, int fq) const {
        const int row0 = u.pm * 256 + wr * 64 + fr, col0 = u.pn * 256 + wc * 32 + 8 * fq;
#pragma unroll
        for (int ai = 0; ai < 2; ++ai)
#pragma unroll
            for (int m = 0; m < 4; ++m) { const int row = row0 + ai * 128 + m * 16; float ss = 0.f;
#pragma unroll
                for (int bj = 0; bj < 2; ++bj) { const f32x4 v0 = acc[ai][bj][m][0], v1 = acc[ai][bj][m][1];
                    *(u32x4*)(E0 + (size_t)row * DM + col0 + bj * 128) = pack8(v0, v1);
                    ss += ((v0[0] * v0[0] + v0[1] * v0[1]) + (v0[2] * v0[2] + v0[3] * v0[3])) + ((v1[0] * v1[0] + v1[1] * v1[1]) + (v1[2] * v1[2] + v1[3] * v1[3])); }
                ss += __shfl_xor(ss, 16); ss += __shfl_xor(ss, 32); if (fq == 0) ssp[(size_t)row * 16 + u.pn * 4 + wc] = ss; }
    }
};
struct EpiFin {
    static constexpr bool PERM = true, AFTER_DRAIN = false, TWOSEG = false;
    const bf16_t* X; float* OUT; const bf16_t* E0; const float* ss3p; const float* gple; const float* gfin; float* ss4; unsigned* cnt;
    __device__ __forceinline__ void operator()(AccT& acc, const Unit& u, int wr, int wc, int fr, int fq) const {
        const int row0 = u.pm * 256 + wr * 64 + fr, col0 = u.pn * 256 + wc * 32 + 8 * fq;
        {
            f32x4 gp[2][2];
#pragma unroll
            for (int bj = 0; bj < 2; ++bj) { gp[bj][0] = *(const f32x4*)(gple + col0 + bj * 128); gp[bj][1] = *(const f32x4*)(gple + col0 + bj * 128 + 4); }
#pragma unroll
            for (int ai = 0; ai < 2; ++ai)
#pragma unroll
                for (int m = 0; m < 4; ++m) { const int row = row0 + ai * 128 + m * 16; const float rs = rstd_from_parts(ss3p, row); float ss = 0.f; const size_t off = (size_t)row * DM + col0;
#pragma unroll
                    for (int bj = 0; bj < 2; ++bj) { f32x4 e0, e1; unpack8(*(const u32x4*)(E0 + off + bj * 128), e0, e1);
                        f32x4 x0, x1; unpack8(*(const u32x4*)(X + off + bj * 128), x0, x1);
                        const f32x4 a0 = acc[ai][bj][m][0], a1 = acc[ai][bj][m][1];
#pragma unroll
                        for (int j = 0; j < 4; ++j) { x0[j] += sigmoid_f(a0[j]) * (e0[j] * rs * gp[bj][0][j]); x1[j] += sigmoid_f(a1[j]) * (e1[j] * rs * gp[bj][1][j]); }
                        acc[ai][bj][m][0] = x0; acc[ai][bj][m][1] = x1;
                        ss += ((x0[0] * x0[0] + x0[1] * x0[1]) + (x0[2] * x0[2] + x0[3] * x0[3])) + ((x1[0] * x1[0] + x1[1] * x1[1]) + (x1[2] * x1[2] + x1[3] * x1[3])); }
                    ss += __shfl_xor(ss, 16); ss += __shfl_xor(ss, 32);
                    if (fq == 0) __hip_atomic_fetch_add(ss4 + row, ss, __ATOMIC_RELAXED, __HIP_MEMORY_SCOPE_AGENT);
                    if (m & 1) __builtin_amdgcn_sched_barrier(0); }
        }
        asm volatile("s_waitcnt vmcnt(0)" ::: "memory");
        unsigned* c = cnt + 64 * u.pm;
        if (fr == 0 && fq == 0) __hip_atomic_fetch_add(c, 1u, __ATOMIC_RELAXED, __HIP_MEMORY_SCOPE_AGENT);
        { unsigned spins = 0;
          while ((unsigned)__builtin_amdgcn_readfirstlane(__hip_atomic_load(c, __ATOMIC_RELAXED, __HIP_MEMORY_SCOPE_AGENT)) < 32u) { __builtin_amdgcn_s_sleep(2); if (++spins > (1u << 22)) break; } }
        asm volatile("" ::: "memory");
        f32x4 gf[2][2];
#pragma unroll
        for (int bj = 0; bj < 2; ++bj) { gf[bj][0] = *(const f32x4*)(gfin + col0 + bj * 128); gf[bj][1] = *(const f32x4*)(gfin + col0 + bj * 128 + 4); }
#pragma unroll
        for (int ai = 0; ai < 2; ++ai)
#pragma unroll
            for (int m = 0; m < 4; ++m) { const int row = row0 + ai * 128 + m * 16; const size_t off = (size_t)row * DM + col0;
                const float rs = __builtin_amdgcn_rsqf(__hip_atomic_load(ss4 + row, __ATOMIC_RELAXED, __HIP_MEMORY_SCOPE_AGENT) * (1.f / DM) + EPS);
#pragma unroll
                for (int bj = 0; bj < 2; ++bj) { *(f32x4*)(OUT + off + bj * 128) = acc[ai][bj][m][0] * rs * gf[bj][0]; *(f32x4*)(OUT + off + bj * 128 + 4) = acc[ai][bj][m][1] * rs * gf[bj][1]; } }
    }
};

#define LDS_WAIT() asm volatile("s_waitcnt lgkmcnt(0)" ::: "memory")
__device__ __forceinline__ void transpose_item(const float* W, int K, int N, int srcn0, const float* gs, bf16_t* WT, int dstn0, int k0, LAS float* scr, int lane) {
    float tv[32];
#pragma unroll
    for (int i = 0; i < 32; ++i) tv[i] = W[(size_t)(k0 + 2 * i + (lane >> 5)) * N + srcn0 + (lane & 31)];
    if (gs) {
#pragma unroll
        for (int i = 0; i < 32; ++i) tv[i] *= gs[k0 + 2 * i + (lane >> 5)]; }
#pragma unroll
    for (int i = 0; i < 32; ++i) scr[(2 * i + (lane >> 5)) * 33 + (lane & 31)] = tv[i];
    LDS_WAIT(); asm volatile("" ::: "memory");
    const int c = lane & 7;
#pragma unroll
    for (int j = 0; j < 4; ++j) { const int n = (lane >> 3) + 8 * j; const LAS float* s = scr + (8 * c) * 33 + n;
        u32x4 o; o.x = cvt_pk_bf16(s[0 * 33], s[1 * 33]); o.y = cvt_pk_bf16(s[2 * 33], s[3 * 33]); o.z = cvt_pk_bf16(s[4 * 33], s[5 * 33]); o.w = cvt_pk_bf16(s[6 * 33], s[7 * 33]);
        *(u32x4*)(WT + (size_t)(dstn0 + n) * K + k0 + 8 * c) = o; }
    LDS_WAIT(); asm volatile("" ::: "memory");
}
__device__ __forceinline__ int win_src(int n0) {
    if (n0 < 3072 || n0 >= 5120) return n0;
    const int w = n0 - 3072, q = w >> 8, r = w & 255;
    return (r < 128) ? 3072 + 128 * q + r : 4096 + 128 * q + (r - 128);
}
__device__ __forceinline__ int up_src(int n0) { return ((n0 & 255) >> 7) * DFF + 128 * (n0 >> 8) + (n0 & 127); }
__device__ __forceinline__ void p0_prologue(LAS unsigned char* lds, const Params& P, int G, int bid) {
    int tid = threadIdx.x; asm volatile("" : "+v"(tid)); const int lane = tid & 63, wave = tid >> 6;
    LAS float* scr = (LAS float*)(lds + wave * 16384);
    unsigned char* ws = P.ws;
    const int gw = bid * 8 + wave, NGW = G * 8;
    constexpr int I_IN = 16 * 224, I_UP = 16 * 192, I_DN = 48 * 32, I_SQ = 16 * 32, I_PLE = 4 * 32, I_RG = 128;
    constexpr int NITEMS = I_IN + I_UP + I_DN + 4 * I_SQ + I_PLE + I_RG;
    for (int it = gw; it < NITEMS; it += NGW) {
        int r = it;
        if (r < I_IN) { const int kb = r / 224, nb = r % 224; transpose_item(P.w_in, DM, DIN, win_src(nb * 32), P.g_mix, (bf16_t*)(ws + WS_WIN), nb * 32, kb * 64, scr, lane); continue; } r -= I_IN;
        if (r < I_UP) { const int kb = r / 192, nb = r % 192; transpose_item(P.w_up, DM, 2 * DFF, up_src(nb * 32), P.g_ffn, (bf16_t*)(ws + WS_WUP), nb * 32, kb * 64, scr, lane); continue; } r -= I_UP;
        if (r < I_DN) { const int kb = r / 32, nb = r % 32; transpose_item(P.w_down, DFF, DM, nb * 32, nullptr, (bf16_t*)(ws + WS_WDOWN), nb * 32, kb * 64, scr, lane); continue; } r -= I_DN;
        if (r < 4 * I_SQ) { const int w = r / I_SQ, rr = r % I_SQ, kb = rr / 32, nb = rr % 32;
            const float* W = (w == 0) ? P.w_proj_a : (w == 1) ? P.w_proj_b : (w == 2) ? P.w_out : P.w_ple_gate;
            bf16_t* WT = (bf16_t*)(ws + ((w == 0) ? WS_WPA : (w == 1) ? WS_WPB : (w == 2) ? WS_WOUT : WS_WGATE));
            transpose_item(W, DM, DM, nb * 32, nullptr, WT, nb * 32, kb * 64, scr, lane); continue; } r -= 4 * I_SQ;
        if (r < I_PLE) { const int kb = r / 32, nb = r % 32; transpose_item(P.w_ple_proj, DPLE, DM, nb * 32, nullptr, (bf16_t*)(ws + WS_WPLE), nb * 32, kb * 64, scr, lane); continue; } r -= I_PLE;
        { const int g = r >> 6, h = (r >> 3) & 7, sub = r & 7, kb = sub >> 2, nb = sub & 3;
          const float* W = (g ? P.w_rg_x : P.w_rg_a) + (size_t)h * 128 * 128;
          transpose_item(W, 128, 128, nb * 32, nullptr, (bf16_t*)(ws + WS_WRG) + (size_t)(g * 8 + h) * 128 * 128, nb * 32, kb * 64, scr, lane); }
    }
    bf16_t* XB = (bf16_t*)(ws + WS_XB); float* rnorm = (float*)(ws + WS_RSTD1);
    for (int m0 = 2 * gw; m0 < T; m0 += 2 * NGW) {
        f32x4 v[2][4]; float s[2];
#pragma unroll
        for (int rr = 0; rr < 2; ++rr) { const f32x4* xr = (const f32x4*)(P.x + (size_t)(m0 + rr) * DM) + lane;
#pragma unroll
            for (int j = 0; j < 4; ++j) v[rr][j] = xr[64 * j]; }
#pragma unroll
        for (int rr = 0; rr < 2; ++rr) { float a = 0.f;
#pragma unroll
            for (int j = 0; j < 4; ++j) a += (v[rr][j][0] * v[rr][j][0] + v[rr][j][1] * v[rr][j][1]) + (v[rr][j][2] * v[rr][j][2] + v[rr][j][3] * v[rr][j][3]);
            s[rr] = wave_sum(a); }
#pragma unroll
        for (int rr = 0; rr < 2; ++rr) { u32x2* o8 = (u32x2*)(XB + (size_t)(m0 + rr) * DM) + lane; const float rs = __builtin_amdgcn_rsqf(s[rr] * (1.f / DM) + EPS);
            if (lane == 0) rnorm[m0 + rr] = __builtin_amdgcn_sqrtf(s[rr] * (1.f / DM) + EPS);
#pragma unroll
            for (int j = 0; j < 4; ++j) { u32x2 w; w.x = cvt_pk_bf16(v[rr][j][0] * rs, v[rr][j][1] * rs); w.y = cvt_pk_bf16(v[rr][j][2] * rs, v[rr][j][3] * rs); o8[64 * j] = w; } }
    }
    { float* ss4 = (float*)(ws + WS_SS4P); for (int i = bid * NTHREADS + tid; i < T; i += G * NTHREADS) ss4[i] = 0.f; }
    bf16_t* PB = (bf16_t*)(ws + WS_PB);
    for (size_t i = (size_t)bid * NTHREADS + tid; i < (size_t)T * DPLE / 8; i += (size_t)G * NTHREADS) {
        const f32x4 a = *(const f32x4*)(P.p + i * 8), b = *(const f32x4*)(P.p + i * 8 + 4);
        *(u32x4*)(PB + i * 8) = pack8(a, b);
    }
}

constexpr int RG_ROWB = 272, RG_TILEB = 256 * RG_ROWB;
__device__ __forceinline__ void rg_build_tile(const bf16_t* xrb  , int s, LAS unsigned char* tile, const LAS float* cw, int o, int rg) {
    const bool first = (s == 0 && rg == 0);
    const GAS bf16_t* p = (const GAS bf16_t*)xrb + (size_t)((first ? 0 : s * 256 + 8 * rg - 3) * DM + 8 * o);
    u32x4 raw[11];
#pragma unroll
    for (int i = 0; i < 11; ++i) { raw[i] = *(const GAS u32x4*)p; p += (first && i < 3) ? 0 : DM; asm volatile("" : "+v"(p)); }
    if (first) { raw[0] = (u32x4){0u, 0u, 0u, 0u}; raw[1] = raw[0]; raw[2] = raw[0]; }
#pragma unroll
    for (int c = 0; c < 2; ++c) {
        f32x4 w[5];
#pragma unroll
        for (int k = 0; k < 5; ++k) w[k] = *(const LAS f32x4*)(cw + k * 128 + 8 * o + 4 * c);
        f32x4 u[4];
#pragma unroll
        for (int i = 0; i < 3; ++i) u[i] = (f32x4){bf_lo(raw[i][2 * c]), bf_hi(raw[i][2 * c]), bf_lo(raw[i][2 * c + 1]), bf_hi(raw[i][2 * c + 1])};
#pragma unroll
        for (int r = 0; r < 8; ++r) {
            u[(r + 3) & 3] = (f32x4){bf_lo(raw[r + 3][2 * c]), bf_hi(raw[r + 3][2 * c]), bf_lo(raw[r + 3][2 * c + 1]), bf_hi(raw[r + 3][2 * c + 1])};
            f32x4 y = w[4];
#pragma unroll
            for (int k = 0; k < 4; ++k) y += w[k] * u[(r + k) & 3];
            u32x2 pk; pk.x = cvt_pk_bf16(y[0], y[1]); pk.y = cvt_pk_bf16(y[2], y[3]);
            *(LAS u32x2*)(tile + (8 * rg + r) * RG_ROWB + o * 16 + c * 8) = pk;
        }
        __builtin_amdgcn_sched_barrier(0);
    }
}
__device__ __forceinline__ void p2_rglru(LAS unsigned char* lds, const Params& P, const bf16_t* XR, const bf16_t* GIN, bf16_t* YO, const bf16_t* WRG, bf16_t* CB, const bf16_t* CCX, int G, int bid) {
    int tid = threadIdx.x; asm volatile("" : "+v"(tid)); const int lane = tid & 63, wid = __builtin_amdgcn_readfirstlane(tid >> 6), fr = lane & 15, fq = lane >> 4, cgi = wid & 1, tq = wid >> 1;
    const int o = tid & 15, rg = tid >> 4;
    LAS float* summ = (LAS float*)(lds + 2 * RG_TILEB);
    LAS float* cw = (LAS float*)(lds + 2 * RG_TILEB + 2048);
    for (int item = bid; item < 256; item += G) {
        const int b = item >> 5, h = (item >> 2) & 7, q = item & 3, chb = h * 128, cl = 32 * q + 16 * cgi + fr, cho = chb + cl;
        const size_t rowbase = (size_t)b * SEQ;
        const bf16_t* xrb = XR + rowbase * DM + chb;
        const GAS bf16_t* gib = (const GAS bf16_t*)GIN + rowbase * DM; GAS bf16_t* gyb = (GAS bf16_t*)YO + rowbase * DM;
        __syncthreads();
        if (tid < 128) {
#pragma unroll
            for (int k = 0; k < 4; ++k) cw[k * 128 + tid] = P.rnn_conv_w[k * DM + chb + tid];
            cw[4 * 128 + tid] = P.rnn_conv_b[chb + tid]; }
        const GAS bf16_t* wrow = (const GAS bf16_t*)WRG + ((size_t)h * 128 + cl) * 128 + 8 * fq;
        const int c4 = 32 * q + 16 * cgi + 4 * fq;
        const f32x4 ba = *(const f32x4*)(P.b_rg_a + chb + c4), bx = *(const f32x4*)(P.b_rg_x + chb + c4);
        f32x4 sp16; { const f32x4 lam = *(const f32x4*)(P.lru_lambda + chb + c4);
#pragma unroll
            for (int j = 0; j < 4; ++j) sp16[j] = 16.f * log1pf(expf(-lam[j])); }
        f32x4 Hrun = {0.f, 0.f, 0.f, 0.f};
        bf16x8 Ba[4], Bx[4];
#pragma unroll
        for (int kk = 0; kk < 4; ++kk) { Ba[kk] = *(const GAS bf16x8*)(wrow + 32 * kk); Bx[kk] = *(const GAS bf16x8*)(wrow + 8 * 128 * 128 + 32 * kk); }
        __syncthreads();
        rg_build_tile(xrb, 0, lds, cw, o, rg);
        __syncthreads();
        for (int s = 0; s < 16; ++s) {
            LAS unsigned char* tl = lds + (s & 1) * RG_TILEB;
            const bool has_next = (s + 1 < 16);
            unsigned goff = (unsigned)((s * 256 + 64 * tq + fr) * DM + chb + c4); asm volatile("" : "+v"(goff));
            u32x2 gvp[4];
#pragma unroll
            for (int m = 0; m < 4; ++m) gvp[m] = *(const GAS u32x2*)(gib + goff + (unsigned)(16 * m * DM));
            __builtin_amdgcn_sched_barrier(0);
            f32x4 aa[4], ax[4];
#pragma unroll
            for (int m = 0; m < 4; ++m) { aa[m] = (f32x4){0.f, 0.f, 0.f, 0.f}; ax[m] = (f32x4){0.f, 0.f, 0.f, 0.f}; }
#pragma unroll
            for (int m = 0; m < 4; ++m)
#pragma unroll
                for (int kk = 0; kk < 4; ++kk) { const bf16x8 A = *(const LAS bf16x8*)(tl + (64 * tq + 16 * m + fr) * RG_ROWB + (32 * kk + 8 * fq) * 2);
                    aa[m] = __builtin_amdgcn_mfma_f32_16x16x32_bf16(Ba[kk], A, aa[m], 0, 0, 0); ax[m] = __builtin_amdgcn_mfma_f32_16x16x32_bf16(Bx[kk], A, ax[m], 0, 0, 0); }
            __builtin_amdgcn_sched_barrier(0);
            f32x4 hl[4], pl[4]; f32x4 Pc = {1.f, 1.f, 1.f, 1.f}, Hc = {0.f, 0.f, 0.f, 0.f};
#define RG_SHR_F(v, d, oldv) __int_as_float(__builtin_amdgcn_update_dpp(__float_as_int(oldv), __float_as_int(v), 0x110 + (d), 0xf, 0xf, false))
#define RG_B15_F(v) __int_as_float(__builtin_amdgcn_ds_swizzle(__float_as_int(v), 0x1F0))
#pragma unroll
            for (int m = 0; m < 4; ++m) {
                const u32x2 xw = *(const LAS u32x2*)(tl + (64 * tq + 16 * m + fr) * RG_ROWB + c4 * 2);
                const f32x4 xv = {bf_lo(xw.x), bf_hi(xw.x), bf_lo(xw.y), bf_hi(xw.y)};
                f32x4 Pv, Hv;
#pragma unroll
                for (int j = 0; j < 4; ++j) {
                    const float r = sigmoid_f(aa[m][j] + ba[j]), ig = sigmoid_f(ax[m][j] + bx[j]);
                    const float y2 = -sp16[j] * r;
                    const float a = __builtin_amdgcn_exp2f(y2 * 0.7213475204444817f);
                    const float ser = -y2 * (1.f + y2 * 0.5f * (1.f + y2 * (1.f / 3.f) * (1.f + y2 * 0.25f * (1.f + y2 * 0.2f * (1.f + y2 * (1.f / 6.f))))));
                    const float em = (y2 > -0.5f) ? ser : 1.f - a * a;
                    Pv[j] = a; Hv[j] = __builtin_amdgcn_sqrtf(em) * ig * xv[j];
                }
#pragma unroll
                for (int j = 0; j < 4; ++j) {
                    float Pj = Pv[j], Hj = Hv[j];
                    { const float Pp = RG_SHR_F(Pj, 1, 1.f), Hp = RG_SHR_F(Hj, 1, 0.f); Hj = Pj * Hp + Hj; Pj = Pp * Pj; }
                    { const float Pp = RG_SHR_F(Pj, 2, 1.f), Hp = RG_SHR_F(Hj, 2, 0.f); Hj = Pj * Hp + Hj; Pj = Pp * Pj; }
                    { const float Pp = RG_SHR_F(Pj, 4, 1.f), Hp = RG_SHR_F(Hj, 4, 0.f); Hj = Pj * Hp + Hj; Pj = Pp * Pj; }
                    { const float Pp = RG_SHR_F(Pj, 8, 1.f), Hp = RG_SHR_F(Hj, 8, 0.f); Hj = Pj * Hp + Hj; Pj = Pp * Pj; }
                    const float Pt = RG_B15_F(Pj), Ht = RG_B15_F(Hj);
                    hl[m][j] = Pj * Hc[j] + Hj; pl[m][j] = Pc[j] * Pj;
                    Hc[j] = Pt * Hc[j] + Ht; Pc[j] = Pc[j] * Pt;
                }
                __builtin_amdgcn_sched_barrier(0);
            }
            LAS float* sm = summ + (s & 1) * 256;
            if (fr == 0) { LAS float* d = sm + ((tq * 2 + cgi) * 16 + 4 * fq) * 2;
                *(LAS f32x4*)d = (f32x4){Pc[0], Hc[0], Pc[1], Hc[1]}; *(LAS f32x4*)(d + 4) = (f32x4){Pc[2], Hc[2], Pc[3], Hc[3]}; }
            __builtin_amdgcn_sched_barrier(0);
            if (has_next) rg_build_tile(xrb, s + 1, lds + ((s + 1) & 1) * RG_TILEB, cw, o, rg);
            u32x4 sc_c[4], sc_b[2]; const int sc_r0 = item * 128 + 8 * s + 2 * (tid >> 7), sc_o = tid & 127;
            if (CB) { const bool seq0 = (sc_r0 & (SEQ - 1)) == 0;
#pragma unroll
                for (int i = 0; i < 4; ++i) { const int rr = (seq0 && i < 2) ? sc_r0 : sc_r0 - 2 + i; sc_c[i] = *(const GAS u32x4*)((const GAS bf16_t*)CCX + (size_t)rr * DM + 8 * sc_o); if (seq0 && i < 2) sc_c[i] = (u32x4){0u, 0u, 0u, 0u}; }
#pragma unroll
                for (int i = 0; i < 2; ++i) sc_b[i] = *(const GAS u32x4*)((const GAS bf16_t*)CB + (size_t)(sc_r0 + i) * DM + 8 * sc_o); }
            __syncthreads();
            f32x4 Hs = Hrun, Hall = Hrun;
#pragma unroll
            for (int t = 0; t < 4; ++t) { const LAS float* d = sm + ((t * 2 + cgi) * 16 + 4 * fq) * 2; const f32x4 w0 = *(const LAS f32x4*)d, w1 = *(const LAS f32x4*)(d + 4);
                Hall[0] = w0[0] * Hall[0] + w0[1]; Hall[1] = w0[2] * Hall[1] + w0[3]; Hall[2] = w1[0] * Hall[2] + w1[1]; Hall[3] = w1[2] * Hall[3] + w1[3];
                if (t < tq) Hs = Hall; }
            Hrun = Hall;
#pragma unroll
            for (int m = 0; m < 4; ++m) { const f32x4 hv = hl[m] + pl[m] * Hs; const f32x4 gg = {bf_lo(gvp[m].x), bf_hi(gvp[m].x), bf_lo(gvp[m].y), bf_hi(gvp[m].y)};
                u32x2 pk; pk.x = cvt_pk_bf16(hv[0] * gg[0], hv[1] * gg[1]); pk.y = cvt_pk_bf16(hv[2] * gg[2], hv[3] * gg[3]);
                *(GAS u32x2*)(gyb + goff + (unsigned)(16 * m * DM)) = pk; }
            if (CB) {
                f32x4 w[3][2];
#pragma unroll
                for (int k = 0; k < 3; ++k) { w[k][0] = *(const f32x4*)(P.sc_conv_w + k * DM + 8 * sc_o); w[k][1] = *(const f32x4*)(P.sc_conv_w + k * DM + 8 * sc_o + 4); }
                f32x4 c[4][2];
#pragma unroll
                for (int i = 0; i < 4; ++i) unpack8(sc_c[i], c[i][0], c[i][1]);
#pragma unroll
                for (int i = 0; i < 2; ++i) { f32x4 b0, b1; unpack8(sc_b[i], b0, b1);
                    const f32x4 y0 = b0 * (w[0][0] * c[i][0] + w[1][0] * c[i + 1][0] + w[2][0] * c[i + 2][0]), y1 = b1 * (w[0][1] * c[i][1] + w[1][1] * c[i + 1][1] + w[2][1] * c[i + 2][1]);
                    *(GAS u32x4*)((GAS bf16_t*)CB + (size_t)(sc_r0 + i) * DM + 8 * sc_o) = pack8(y0, y1); }
            }
        }
    }
}
__device__ __forceinline__ void p2_shortconv(const Params& P, bf16_t* CB, const bf16_t* CCX, int G, int bid) {
    const int nth = G * NTHREADS; int tid = threadIdx.x; asm volatile("" : "+v"(tid));
    for (int it = bid * NTHREADS + tid; it < (T / 16) * 128; it += nth) {
        const int o = it & 127, row0 = (it >> 7) * 16;
        f32x4 w[3][2];
#pragma unroll
        for (int k = 0; k < 3; ++k) { w[k][0] = *(const f32x4*)(P.sc_conv_w + k * DM + 8 * o); w[k][1] = *(const f32x4*)(P.sc_conv_w + k * DM + 8 * o + 4); }
        f32x4 p2a = {0.f, 0.f, 0.f, 0.f}, p2b = p2a, p1a = p2a, p1b = p2a;
        if ((row0 & (SEQ - 1)) != 0) { unpack8(*(const u32x4*)(CCX + (size_t)(row0 - 2) * DM + 8 * o), p2a, p2b); unpack8(*(const u32x4*)(CCX + (size_t)(row0 - 1) * DM + 8 * o), p1a, p1b); }
#pragma unroll 4
        for (int r = 0; r < 16; ++r) { const size_t off = (size_t)(row0 + r) * DM + 8 * o;
            f32x4 c0a, c0b, ba, bb; unpack8(*(const u32x4*)(CCX + off), c0a, c0b); unpack8(*(const u32x4*)(CB + off), ba, bb);
            const f32x4 ya = ba * (w[0][0] * p2a + w[1][0] * p1a + w[2][0] * c0a), yb = bb * (w[0][1] * p2b + w[1][1] * p1b + w[2][1] * c0b);
            *(u32x4*)(CB + off) = pack8(ya, yb);
            p2a = p1a; p2b = p1b; p1a = c0a; p1b = c0b; }
    }
}
__device__ __forceinline__ void p6_fixup(const Params& P, const float* halo, bf16_t* ACT, int G, int bid) {
    const int nth = G * NTHREADS; int tid = threadIdx.x; asm volatile("" : "+v"(tid));
    for (int it = bid * NTHREADS + tid; it < (T / 256) * DFF; it += nth) {
        const int pm = it / DFF, c = it % DFF;
        if ((pm & 15) == 0) continue;
        const int cg_ = 256 * (c >> 7) + (c & 127), cv = cg_ + 128;
        const float* hc = halo + (size_t)pm * 4 * (2 * DFF); const float* hp = hc - 4 * (2 * DFF);
        const float g254 = hp[2 * (2 * DFF) + cg_], g255 = hp[3 * (2 * DFF) + cg_], g0 = hc[cg_], g1 = hc[(2 * DFF) + cg_];
        const float v254 = hp[2 * (2 * DFF) + cv], v255 = hp[3 * (2 * DFF) + cv], v0 = hc[cv], v1 = hc[(2 * DFF) + cv];
        const float wg0 = P.ffn_conv_w[c], wg1 = P.ffn_conv_w[2 * DFF + c], wg2 = P.ffn_conv_w[4 * DFF + c], bg = P.ffn_conv_b[c];
        const float wv0 = P.ffn_conv_w[DFF + c], wv1 = P.ffn_conv_w[3 * DFF + c], wv2 = P.ffn_conv_w[5 * DFF + c], bv = P.ffn_conv_b[DFF + c];
        const float r0g = bg + wg0 * g254 + wg1 * g255 + wg2 * g0, r1g = bg + wg0 * g255 + wg1 * g0 + wg2 * g1;
        const float r0v = bv + wv0 * v254 + wv1 * v255 + wv2 * v0, r1v = bv + wv0 * v255 + wv1 * v0 + wv2 * v1;
        ACT[(size_t)(256 * pm) * DFF + c] = f2bf(gelu_f(r0g) * r0v); ACT[(size_t)(256 * pm + 1) * DFF + c] = f2bf(gelu_f(r1g) * r1v);
    }
}
__device__ __forceinline__ void p10_final(const Params& P, const float* ss4p, int G, int bid) {
    int tid = threadIdx.x; asm volatile("" : "+v"(tid)); const int lane = tid & 63, gw = bid * 8 + (tid >> 6), NGW = G * 8;
    f32x4 gf[4];
#pragma unroll
    for (int j = 0; j < 4; ++j) gf[j] = *((const f32x4*)P.g_final + 64 * j + lane);
    for (int m = gw; m < T; m += NGW) { const float rs = rstd_from_parts(ss4p, m); f32x4* xr = (f32x4*)(P.out + (size_t)m * DM) + lane;
#pragma unroll
        for (int j = 0; j < 4; ++j) xr[64 * j] = xr[64 * j] * rs * gf[j]; }
}

#define XB_TMO      128
#define XB_XCNT(j)  (256  + 64 * (j))
#define XB_XSUB(j)  (1280 + 64 * (j))
#define XB_XGEN(j)  (2304 + 64 * (j))
#define XB_TOP      3328
#define XB_TOPGEN   3392
#define XCD_BAR_WORDS 3456
#define XB_SPIN_CAP (1u << 18)

__device__ __forceinline__ unsigned xb_ld(unsigned* p)              { return __hip_atomic_load(p, __ATOMIC_RELAXED, __HIP_MEMORY_SCOPE_AGENT); }
__device__ __forceinline__ unsigned xb_add(unsigned* p, unsigned v) { return __hip_atomic_fetch_add(p, v, __ATOMIC_RELAXED, __HIP_MEMORY_SCOPE_AGENT); }
__device__ __forceinline__ unsigned xb_xcc_id() { return (unsigned)__builtin_amdgcn_s_getreg((3 << 11) | 20) & 0xFu; }
#define XB_SPIN(cond, bar) do { unsigned _sp = 0; while (cond) { __builtin_amdgcn_s_sleep(1); \
    if ((++_sp & 255u) == 0u) { if (xb_ld(&(bar)[XB_TMO])) break; if (_sp > XB_SPIN_CAP) { atomicAdd(&(bar)[XB_TMO], 1u); break; } } } } while (0)

struct XcdBarrier {
    unsigned* bar; unsigned x;
    volatile LAS unsigned* st;
};

__device__ __forceinline__ XcdBarrier xcd_barrier_post(unsigned* bar, volatile LAS unsigned* st) {
    XcdBarrier b; b.bar = bar; b.x = xb_xcc_id(); b.st = st;
    if (threadIdx.x == 0) (void)xb_add(&bar[XB_XCNT(b.x)], 1u);
    return b;
}
__device__ __forceinline__ void xcd_barrier_complete(unsigned* bar, unsigned x, unsigned& nloc, unsigned& nx) {
    const unsigned G = gridDim.x * gridDim.y * gridDim.z;
    unsigned sum, cnt, mine, sp = 0u;
    for (;;) {
        sum = 0u; cnt = 0u; mine = 0u;
#pragma unroll
        for (unsigned j = 0; j < 16; ++j) { const unsigned c = xb_ld(&bar[XB_XCNT(j)]); sum += c; cnt += (c > 0u) ? 1u : 0u; mine = (j == x) ? c : mine; }
        if (sum == G) break;
        __builtin_amdgcn_s_sleep(1);
        if ((++sp & 255u) == 0u) { if (xb_ld(&bar[XB_TMO])) break; if (sp > XB_SPIN_CAP) { atomicAdd(&bar[XB_TMO], 1u); break; } }
    }
    nloc = mine > 0u ? mine : 1u; nx = cnt > 0u ? cnt : 1u;
}

__device__ __forceinline__ void xcd_barrier(const XcdBarrier& b) {
    asm volatile("s_waitcnt vmcnt(0)" ::: "memory");
    __syncthreads();
    if (threadIdx.x == 0) {
        unsigned* bar = b.bar;
        __builtin_amdgcn_s_waitcnt(0);
        unsigned nloc = b.st[0], nx = b.st[1];
        if (nloc == 0u) { xcd_barrier_complete(bar, b.x, nloc, nx); b.st[0] = nloc; b.st[1] = nx; }
        const unsigned old = xb_add(&bar[XB_XSUB(b.x)], 1u);
        const unsigned gen = old / nloc;
        if (old + 1u == (gen + 1u) * nloc) {
            __builtin_amdgcn_fence(__ATOMIC_RELEASE, "agent");
            asm volatile("s_waitcnt vmcnt(0)" ::: "memory");
            const unsigned og = xb_add(&bar[XB_TOP], 1u);
            const unsigned tg = og / nx;
            if (og + 1u == (tg + 1u) * nx) xb_add(&bar[XB_TOPGEN], 1u);
            else XB_SPIN(xb_ld(&bar[XB_TOPGEN]) == tg, bar);
            __builtin_amdgcn_fence(__ATOMIC_ACQUIRE, "agent");
            xb_add(&bar[XB_XGEN(b.x)], 1u);
            asm volatile("s_waitcnt vmcnt(0)" ::: "memory");
        } else {
            XB_SPIN(xb_ld(&bar[XB_XGEN(b.x)]) == gen, bar);
            __builtin_amdgcn_fence(__ATOMIC_ACQUIRE, "agent");
            asm volatile("s_waitcnt vmcnt(0)" ::: "memory");
        }
    }
    __syncthreads();
}

__global__ void __launch_bounds__(NTHREADS, 2) mega_fwd(Params P) {
    extern __shared__ __attribute__((aligned(16))) unsigned char lds_raw[];
    LAS unsigned char* lds = (LAS unsigned char*)lds_raw;
    cg::grid_group grid = cg::this_grid();
    const int G = gridDim.x, bid = blockIdx.x;
    unsigned char* ws = P.ws;
    bf16_t* BIG = (bf16_t*)(ws + WS_BIG);
    bf16_t *B0 = BIG, *B1 = BIG + TS, *B2 = BIG + 2 * TS, *B3 = BIG + 3 * TS, *B4 = BIG + 4 * TS, *B5 = BIG + 5 * TS;
    bf16_t* XB = (bf16_t*)(ws + WS_XB);
    float *ss2p = (float*)(ws + WS_SS2P), *ss3p = (float*)(ws + WS_SS3P), *ss4p = (float*)(ws + WS_SS4P);

    volatile LAS unsigned* bst = (volatile LAS unsigned*)(lds + LDS_BYTES - 64);
    if (threadIdx.x < 2) bst[threadIdx.x] = 0u;
    unsigned* barw = (unsigned*)(ws + WS_BAR);
    if (ws == nullptr) grid.sync();
    __syncthreads();
    XcdBarrier xbar = xcd_barrier_post(barw, bst);
    p0_prologue(lds, P, G, bid);
    if (PROBE_ID == 1) { xcd_barrier(xbar); p0_prologue(lds, P, G, bid); }
    if (PROBE_ID == 3) { for (int i = 0; i < 10; ++i) xcd_barrier(xbar); }
    xcd_barrier(xbar);
    {
        pg8::Gemm g{XB, (const bf16_t*)(ws + WS_WIN), T, DIN, DM}; pg8::StaticOrder S; S.init(T, DIN, G, bid);
        EpiZ E{BIG};
        pg8::gemm_phase<EpiZ, pg8::StaticOrder, true, true>(lds, g, S, E);
        if (PROBE_ID == 5) pg8::gemm_phase<EpiZ, pg8::StaticOrder, true, true>(lds, g, S, E);
    }
    xcd_barrier(xbar);
    if (PROBE_ID == 2) { p2_rglru(lds, P, B0, B1, (bf16_t*)P.out, (const bf16_t*)(ws + WS_WRG), nullptr, nullptr, G, bid); }
    if (G == 256) p2_rglru(lds, P, B0, B1, B1, (const bf16_t*)(ws + WS_WRG), B2, B3, G, bid);
    else { p2_rglru(lds, P, B0, B1, B1, (const bf16_t*)(ws + WS_WRG), nullptr, nullptr, G, bid); p2_shortconv(P, B2, B3, G, bid); }
    xcd_barrier(xbar);
    {
        pg8::Gemm g{B1, (const bf16_t*)(ws + WS_WPA), T, DM, DM, B2, (const bf16_t*)(ws + WS_WPB)}; pg8::StaticOrder2 S; S.init(T, DM, G, bid);
        EpiMerge E{B4, B5, B0};
        pg8::gemm_phase<EpiMerge, pg8::StaticOrder2, true, true>(lds, g, S, E);
    }
    xcd_barrier(xbar);
    {
        pg8::Gemm g{B0, (const bf16_t*)(ws + WS_WOUT), T, DM, DM}; pg8::StaticOrder S; S.init(T, DM, G, bid);
        EpiResB<true, true> E{XB, (const float*)(ws + WS_RSTD1), XB, ss2p};
        pg8::gemm_phase<EpiResB<true, true>, pg8::StaticOrder, true, true>(lds, g, S, E);
    }
    xcd_barrier(xbar);
    {
        pg8::Gemm g{XB, (const bf16_t*)(ws + WS_WUP), T, 2 * DFF, DM}; pg8::StaticOrder S; S.init(T, 2 * DFF, G, bid);
        EpiAct E{B0, ss2p, P.ffn_conv_w, P.ffn_conv_b, (float*)B4, (LAS float*)(lds + 131072)};
        pg8::gemm_phase<EpiAct, pg8::StaticOrder, true, true>(lds, g, S, E);
        if (PROBE_ID == 6) pg8::gemm_phase<EpiAct, pg8::StaticOrder, true, true>(lds, g, S, E);
    }
    xcd_barrier(xbar);
    p6_fixup(P, (const float*)B4, B0, G, bid);
    xcd_barrier(xbar);
    {
        pg8::Gemm g{B0, (const bf16_t*)(ws + WS_WDOWN), T, DM, DFF}; pg8::StaticOrder S; S.init(T, DM, G, bid);
        EpiResB<false, false> E{XB, nullptr, B5, nullptr};
        pg8::gemm_phase<EpiResB<false, false>, pg8::StaticOrder, true, true>(lds, g, S, E);
    }
    {
        pg8::Gemm g{(const bf16_t*)(ws + WS_PB), (const bf16_t*)(ws + WS_WPLE), T, DM, DPLE}; pg8::StaticOrder S; S.init(T, DM, G, bid);
        EpiE0 E{B3, ss3p};
        pg8::gemm_phase<EpiE0, pg8::StaticOrder, true, true>(lds, g, S, E);
    }
    xcd_barrier(xbar);
    {
        pg8::Gemm g{B5, (const bf16_t*)(ws + WS_WGATE), T, DM, DM}; pg8::StaticOrder S; S.init(T, DM, G, bid);
        EpiFin E{B5, P.out, B3, ss3p, P.g_ple, P.g_final, ss4p, (unsigned*)(ws + WS_BAR + 16384)};
        pg8::gemm_phase<EpiFin, pg8::StaticOrder, true, true>(lds, g, S, E);
    }
}

extern "C" void kernel_launch(void* const* d_in, const int* in_sizes, int n_in, void* d_out, int out_size, void* d_ws, size_t ws_size, hipStream_t stream) {
    static int grid = 0;
    if (grid == 0) {
        if (n_in != 24 || in_sizes[0] != T * DM || out_size != T * DM || ws_size < WS_END) { fprintf(stderr, "kernel_launch: unexpected shapes (n_in %d, in0 %d, out %d, ws %zu); nothing launched\n", n_in, n_in > 0 ? in_sizes[0] : -1, out_size, ws_size); grid = -1; return; }
        int dev = 0, cus = 0, per_cu = 0;
        if (hipGetDevice(&dev) != hipSuccess || hipDeviceGetAttribute(&cus, hipDeviceAttributeMultiprocessorCount, dev) != hipSuccess) { fprintf(stderr, "kernel_launch: device query failed\n"); grid = -1; return; }
        if (hipFuncSetAttribute((const void*)mega_fwd, hipFuncAttributeMaxDynamicSharedMemorySize, LDS_BYTES) != hipSuccess) { fprintf(stderr, "kernel_launch: hipFuncSetAttribute failed\n"); grid = -1; return; }
        if (hipOccupancyMaxActiveBlocksPerMultiprocessor(&per_cu, (const void*)mega_fwd, NTHREADS, LDS_BYTES) != hipSuccess || per_cu < 1) { fprintf(stderr, "kernel_launch: occupancy query says %d blocks per CU\n", per_cu); grid = -1; return; }
        grid = cus;
    }
    if (grid < 0) return;
    Params p{};
    const float** pp = (const float**)&p;
    for (int i = 0; i < 24; ++i) pp[i] = (const float*)d_in[i];
    p.out = (float*)d_out; p.ws = (unsigned char*)d_ws;
    if (hipMemsetAsync((char*)d_ws + WS_BAR, 0, 65536, stream) != hipSuccess) { fprintf(stderr, "kernel_launch: hipMemsetAsync of the barrier words failed\n"); return; }
    void* args[] = {&p};
    hipError_t e = hipLaunchCooperativeKernel((const void*)mega_fwd, dim3(grid), dim3(NTHREADS), args, LDS_BYTES, stream);
    if (e != hipSuccess) fprintf(stderr, "kernel_launch: cooperative launch failed: %s (grid %d)\n", hipGetErrorString(e), grid);
}
```

```cpp
#include <hip/hip_runtime.h>
#include <hip/hip_cooperative_groups.h>
#include <cstdio>
#include <cstdint>
namespace cg = cooperative_groups;
namespace pg8 {
#define PG8_LAS __attribute__((address_space(3)))
typedef unsigned short bf16_t;
typedef short bf16x8 __attribute__((ext_vector_type(8)));
typedef float f32x4 __attribute__((ext_vector_type(4)));
typedef unsigned u32x4 __attribute__((ext_vector_type(4)));
constexpr int BM = 256, BK = 64, HALF = 128, HTB = HALF * BK * 2  , STAGE_BYTES = 8 * HTB, NXCD = 8, WGM = 4;

__host__ __device__ __forceinline__ int lds_byte(int r, int c) { const int st = (r >> 4) * 2 + (c >> 5), rr = r & 15, cc = c & 31, ob = rr * 64 + cc * 2; return st * 1024 + (ob ^ (((ob >> 9) & 1) << 5)); }
__host__ __device__ __forceinline__ void stage_rc(int b, int& R, int& C) { const int st = b / 1024, sb = b % 1024, swz = sb ^ (((sb >> 9) & 1) << 5); R = (st >> 1) * 16 + swz / 64; C = (st & 1) * 32 + (swz % 64) / 2; }
__host__ __device__ __forceinline__ int perm32(int rho) { const int n = rho >> 4, i = rho & 15; return 8 * (i >> 2) + 4 * n + (i & 3); }

struct Unit { int pm, pn, seg; };
struct Gemm { const bf16_t* A; const bf16_t* Bt; int M, N, K; const bf16_t* A2; const bf16_t* Bt2; };

struct StaticOrder {
    int nM, nN, nwg, G, c;
    __host__ __device__ void init(int M, int N, int G_, int c_) { nM = M / BM; nN = N / BM; nwg = nM * nN; G = G_; c = c_; }
    __host__ __device__ bool next(int i, Unit& u) const {
        const long L = (long)i * G + c; if (L >= nwg) return false;
        int wgid = (int)L; { const int q = nwg / NXCD, r = nwg % NXCD, xcd = wgid % NXCD, off = wgid / NXCD; wgid = (xcd < r ? xcd * (q + 1) : r * (q + 1) + (xcd - r) * q) + off; }
        const int nig = WGM * nN, gid = wgid / nig, fm = gid * WGM, gsz = (nM - fm) < WGM ? (nM - fm) : WGM;
        u.pm = fm + ((wgid % nig) % gsz); u.pn = (wgid % nig) / gsz; u.seg = 0; return true;
    }
    __device__ __forceinline__ void a_ready(const Unit&) const {}
    __device__ __forceinline__ void done(const Unit&) const {}
};
struct StaticOrder2 : StaticOrder {
    __host__ __device__ bool next(int i, Unit& u) const { if (!StaticOrder::next(i >> 1, u)) return false; u.seg = i & 1; return true; }
};


__device__ __forceinline__ unsigned cvt_pk_bf16(float lo, float hi) { unsigned r; asm volatile("v_cvt_pk_bf16_f32 %0, %1, %2" : "=v"(r) : "v"(lo), "v"(hi)); return r; }
template <class Epi, class Sched, bool ALIGN_EPI = false, bool SP2 = false>
__device__ __forceinline__ void gemm_phase(PG8_LAS unsigned char* lds, const Gemm g, const Sched& S, const Epi& E) {
    int tid = threadIdx.x; asm volatile("" : "+v"(tid)); const int wid = __builtin_amdgcn_readfirstlane(tid >> 6), lane = tid & 63, wr = wid >> 2, wc = wid & 3, fr = lane & 15, fq = lane >> 4;
    const int K = g.K, nt = K / BK;
    unsigned voffA[2], voffB[2];
#pragma unroll
    for (int i = 0; i < 2; ++i) { int R, C; stage_rc(tid * 16 + i * 8192, R, C); const int Rb = Epi::PERM ? ((R & ~31) + perm32(R & 31)) : R;
        voffA[i] = (unsigned)(R * K + C) * 2u; voffB[i] = (unsigned)(Rb * K + C) * 2u; }
    const size_t kstep = (size_t)(BK * 2);
    const size_t hstep = (size_t)HALF * K * 2;
    const size_t tstep = 2 * hstep;
    const unsigned ldsw = (unsigned)wid * 1024u;
    const int aoff = lds_byte(wr * 64 + fr, fq * 8), boff = lds_byte(wc * 32 + fr, fq * 8);
#define PG8_SA(b, h) (((b) * 2 + (h)) * HTB)
#define PG8_SB(b, h) ((4 + (b) * 2 + (h)) * HTB)
#define PG8_STAGE(bufoff, gbase, voff) do { _Pragma("unroll") for (int _i = 0; _i < 2; ++_i) \
        __builtin_amdgcn_global_load_lds((const unsigned*)((const char*)(gbase) + (voff)[_i]), (PG8_LAS unsigned*)(lds + (bufoff) + ldsw + _i * 8192), 16, 0, 0); } while (0)
#define PG8_LDA(dst, b, h) do { _Pragma("unroll") for (int m = 0; m < 4; ++m) _Pragma("unroll") for (int k = 0; k < 2; ++k) dst[m][k] = *(const PG8_LAS bf16x8*)(lds + PG8_SA(b, h) + aoff + m * 2048 + k * 1024); } while (0)
#define PG8_LDB(dst, b, h) do { _Pragma("unroll") for (int n = 0; n < 2; ++n) _Pragma("unroll") for (int k = 0; k < 2; ++k) dst[n][k] = *(const PG8_LAS bf16x8*)(lds + PG8_SB(b, h) + boff + n * 2048 + k * 1024); } while (0)
#define PG8_MMA(ai, bj, At, Bt) do { __builtin_amdgcn_s_setprio(1); _Pragma("unroll") for (int m = 0; m < 4; ++m) _Pragma("unroll") for (int n = 0; n < 2; ++n) _Pragma("unroll") for (int k = 0; k < 2; ++k) \
        acc[ai][bj][m][n] = __builtin_amdgcn_mfma_f32_16x16x32_bf16(Bt[n][k], At[m][k], acc[ai][bj][m][n], 0, 0, 0); __builtin_amdgcn_s_setprio(0); } while (0)
#define PG8_WAIT_V(n) asm volatile("s_waitcnt vmcnt(" #n ")" ::: "memory")
#define PG8_WAIT_L(n) asm volatile("s_waitcnt lgkmcnt(" #n ")" ::: "memory")
#define PG8_BAR __builtin_amdgcn_s_barrier()
#define PG8_SCHED __builtin_amdgcn_sched_barrier(0)
    Unit cur, nxt; int ui = 0;
    if (!S.next(0, cur)) return;
    f32x4 acc[2][2][4][2];
#pragma unroll
    for (int a = 0; a < 2; ++a)
#pragma unroll
        for (int b = 0; b < 2; ++b)
#pragma unroll
            for (int m = 0; m < 4; ++m)
#pragma unroll
                for (int n = 0; n < 2; ++n) acc[a][b][m][n] = (f32x4){0.f, 0.f, 0.f, 0.f};
    bf16x8 At[4][2], B0[2][2], B1[2][2];
    const char* cA = (const char*)(cur.seg ? g.A2 : g.A) + (size_t)cur.pm * tstep; const char* cB = (const char*)(cur.seg ? g.Bt2 : g.Bt) + (size_t)cur.pn * tstep;
    S.a_ready(cur);
    if constexpr (SP2) {
        PG8_STAGE(PG8_SB(0, 0), cB, voffB); PG8_STAGE(PG8_SB(0, 1), cB + hstep, voffB); PG8_STAGE(PG8_SA(0, 0), cA, voffA); PG8_STAGE(PG8_SA(0, 1), cA + hstep, voffA);
        if (wr == 1) PG8_BAR;
        PG8_WAIT_V(2); PG8_BAR;
        PG8_STAGE(PG8_SB(1, 0), cB + kstep, voffB); PG8_STAGE(PG8_SA(1, 0), cA + kstep, voffA); PG8_STAGE(PG8_SB(1, 1), cB + hstep + kstep, voffB);
        PG8_WAIT_V(6); PG8_BAR;
    } else {
        PG8_STAGE(PG8_SB(0, 0), cB, voffB); PG8_STAGE(PG8_SA(0, 0), cA, voffA); PG8_STAGE(PG8_SB(0, 1), cB + hstep, voffB); PG8_STAGE(PG8_SA(0, 1), cA + hstep, voffA);
        if (wr == 1) PG8_BAR;
        PG8_WAIT_V(4); PG8_BAR;
        PG8_STAGE(PG8_SB(1, 0), cB + kstep, voffB); PG8_STAGE(PG8_SA(1, 0), cA + kstep, voffA); PG8_STAGE(PG8_SB(1, 1), cB + hstep + kstep, voffB);
        PG8_WAIT_V(6); PG8_BAR;
    }
    for (;;) {
        const bool has_next = S.next(ui + 1, nxt);
        const char* nA = has_next ? (const char*)(nxt.seg ? g.A2 : g.A) + (size_t)nxt.pm * tstep : cA; const char* nB = has_next ? (const char*)(nxt.seg ? g.Bt2 : g.Bt) + (size_t)nxt.pn * tstep : cB;
        for (int t = 0; t < nt; t += 2) {
            const bool last = (t == nt - 2);
            const char* a1 = cA + (size_t)(t + 1) * kstep;
            const char* a2 = last ? nA : cA + (size_t)(t + 2) * kstep; const char* b2 = last ? nB : cB + (size_t)(t + 2) * kstep;
            const char* a3 = a2 + kstep; const char* b3 = b2 + kstep;
            if (last && has_next) S.a_ready(nxt);
            if constexpr (SP2) {
            PG8_LDB(B0, 0, 0); PG8_LDB(B1, 0, 1); PG8_SCHED; PG8_LDA(At, 0, 0); PG8_STAGE(PG8_SA(1, 1), a1 + hstep, voffA);
            PG8_WAIT_V(8); PG8_WAIT_L(0); PG8_BAR; PG8_MMA(0, 0, At, B0); PG8_MMA(0, 1, At, B1); PG8_BAR; PG8_SCHED;
            PG8_LDA(At, 0, 1); PG8_STAGE(PG8_SB(0, 0), b2, voffB); PG8_STAGE(PG8_SB(0, 1), b2 + hstep, voffB); PG8_STAGE(PG8_SA(0, 0), a2, voffA);
            PG8_WAIT_V(8); PG8_WAIT_L(0); PG8_BAR; PG8_MMA(1, 0, At, B0); PG8_MMA(1, 1, At, B1); PG8_BAR; PG8_SCHED;
            PG8_LDB(B0, 1, 0); PG8_LDB(B1, 1, 1); PG8_SCHED; PG8_LDA(At, 1, 0); PG8_STAGE(PG8_SA(0, 1), a2 + hstep, voffA);
            PG8_WAIT_V(8); PG8_WAIT_L(0); PG8_BAR; PG8_MMA(0, 0, At, B0); PG8_MMA(0, 1, At, B1); PG8_BAR; PG8_SCHED;
            PG8_LDA(At, 1, 1); PG8_STAGE(PG8_SB(1, 0), b3, voffB); PG8_STAGE(PG8_SB(1, 1), b3 + hstep, voffB); PG8_STAGE(PG8_SA(1, 0), a3, voffA);
            PG8_WAIT_V(8); PG8_WAIT_L(0); PG8_BAR; PG8_MMA(1, 0, At, B0); PG8_MMA(1, 1, At, B1); PG8_BAR; PG8_SCHED;
            } else {
            PG8_LDB(B0, 0, 0); PG8_SCHED; PG8_LDA(At, 0, 0); PG8_STAGE(PG8_SA(1, 1), a1 + hstep, voffA);
            PG8_WAIT_L(8); PG8_BAR; PG8_WAIT_L(0); PG8_MMA(0, 0, At, B0); PG8_BAR; PG8_SCHED;
            PG8_LDB(B1, 0, 1); PG8_STAGE(PG8_SB(0, 0), b2, voffB);
            PG8_BAR; PG8_WAIT_L(0); PG8_MMA(0, 1, At, B1); PG8_BAR;
            PG8_LDA(At, 0, 1); PG8_STAGE(PG8_SA(0, 0), a2, voffA);
            PG8_BAR; PG8_WAIT_L(0); PG8_MMA(1, 0, At, B0); PG8_BAR; PG8_SCHED;
            PG8_STAGE(PG8_SB(0, 1), b2 + hstep, voffB);
            PG8_WAIT_V(6); PG8_BAR; PG8_MMA(1, 1, At, B1); PG8_BAR;
            PG8_LDB(B0, 1, 0); PG8_SCHED; PG8_LDA(At, 1, 0); PG8_STAGE(PG8_SA(0, 1), a2 + hstep, voffA);
            PG8_WAIT_L(8); PG8_BAR; PG8_WAIT_L(0); PG8_MMA(0, 0, At, B0); PG8_BAR; PG8_SCHED;
            PG8_LDB(B1, 1, 1); PG8_STAGE(PG8_SB(1, 0), b3, voffB);
            PG8_BAR; PG8_WAIT_L(0); PG8_MMA(0, 1, At, B1); PG8_BAR;
            PG8_LDA(At, 1, 1); PG8_STAGE(PG8_SA(1, 0), a3, voffA);
            PG8_BAR; PG8_WAIT_L(0); PG8_MMA(1, 0, At, B0); PG8_BAR; PG8_SCHED;
            PG8_STAGE(PG8_SB(1, 1), b3 + hstep, voffB);
            PG8_WAIT_V(6); PG8_BAR; PG8_MMA(1, 1, At, B1); PG8_BAR;
            }
        }
        if constexpr (ALIGN_EPI) { if (wr == 0) PG8_BAR; }
        if constexpr (!Epi::AFTER_DRAIN) { E(acc, cur, wr, wc, fr, fq); S.done(cur); }
        if (!has_next) break;
        if (!Epi::TWOSEG || cur.seg != 0) {
#pragma unroll
        for (int a = 0; a < 2; ++a)
#pragma unroll
            for (int b = 0; b < 2; ++b)
#pragma unroll
                for (int m = 0; m < 4; ++m)
#pragma unroll
                    for (int n = 0; n < 2; ++n) acc[a][b][m][n] = (f32x4){0.f, 0.f, 0.f, 0.f};
        }
        cur = nxt; cA = nA; cB = nB; ++ui;
        if constexpr (ALIGN_EPI) { if (wr == 1) PG8_BAR; }
    }
    PG8_WAIT_V(0);
    if constexpr (!ALIGN_EPI) { if (wr == 0) PG8_BAR; }
    PG8_BAR;
    if constexpr (Epi::AFTER_DRAIN) { E.fused(acc, cur, wr, wc, fr, fq, lds, wid, lane); S.done(cur); }
#undef PG8_SA
#undef PG8_SB
#undef PG8_STAGE
#undef PG8_LDA
#undef PG8_LDB
#undef PG8_MMA
#undef PG8_WAIT_V
#undef PG8_WAIT_L
#undef PG8_BAR
#undef PG8_SCHED
}
}
#define GAS __attribute__((address_space(1)))
#define LAS __attribute__((address_space(3)))
typedef unsigned short bf16_t;
typedef short bf16x8 __attribute__((ext_vector_type(8)));
typedef float f32x4 __attribute__((ext_vector_type(4)));
typedef unsigned u32x4 __attribute__((ext_vector_type(4)));
typedef unsigned u32x2 __attribute__((ext_vector_type(2)));
using pg8::Unit;
using pg8::cvt_pk_bf16;

constexpr int T = 32768, SEQ = 4096, DM = 1024, DIN = 7168, DFF = 3072, DPLE = 256, TH = 16384;
constexpr float EPS = 1e-6f;
constexpr size_t MiB = 1u << 20;
constexpr size_t TS = (size_t)T * DM;
constexpr size_t WS_BAR = 512 * 1024;
constexpr size_t WS_RSTD1 = 0, WS_SS2P = 1 * MiB, WS_SS3P = 3 * MiB, WS_SS4P = 5 * MiB;
constexpr size_t WS_WIN = 7 * MiB, WS_WUP = 21 * MiB, WS_WDOWN = 33 * MiB, WS_WPA = 39 * MiB, WS_WPB = 41 * MiB, WS_WOUT = 43 * MiB, WS_WGATE = 45 * MiB;
constexpr size_t WS_WPLE = 47 * MiB, WS_WRG = 47 * MiB + 512 * 1024;
constexpr size_t WS_XB = 48 * MiB, WS_BIG = 112 * MiB, WS_PB = 496 * MiB, WS_END = 512 * MiB;
constexpr int LDS_BYTES = 147456;
constexpr int NTHREADS = 512;
#ifndef PROBE_ID
#define PROBE_ID 0
#endif

struct Params {
    const float *x, *p, *g_mix, *w_in, *rnn_conv_w, *rnn_conv_b, *w_rg_a, *b_rg_a, *w_rg_x, *b_rg_x, *lru_lambda, *sc_conv_w, *w_proj_a, *w_proj_b, *w_out, *g_ffn,
        *w_up, *ffn_conv_w, *ffn_conv_b, *w_down, *w_ple_gate, *w_ple_proj, *g_ple, *g_final;
    float* out; unsigned char* ws;
};

__device__ __forceinline__ float bf_lo(unsigned w) { return __uint_as_float(w << 16); }
__device__ __forceinline__ float bf_hi(unsigned w) { return __uint_as_float(w & 0xffff0000u); }
__device__ __forceinline__ float bf2f(bf16_t b) { return __uint_as_float(((unsigned)b) << 16); }
__device__ __forceinline__ bf16_t f2bf(float f) { return (bf16_t)(cvt_pk_bf16(f, 0.f) & 0xffffu); }
__device__ __forceinline__ float sigmoid_f(float x) { return __builtin_amdgcn_rcpf(1.f + __builtin_amdgcn_exp2f(-1.4426950408889634f * x)); }
__device__ __forceinline__ float gelu_f(float x) { const float u = x * (1.f + 0.044715f * x * x); return x * __builtin_amdgcn_rcpf(1.f + __builtin_amdgcn_exp2f(-2.302208198f * u)); }
__device__ __forceinline__ u32x4 pack8(const f32x4 a, const f32x4 b) { u32x4 w; w.x = cvt_pk_bf16(a[0], a[1]); w.y = cvt_pk_bf16(a[2], a[3]); w.z = cvt_pk_bf16(b[0], b[1]); w.w = cvt_pk_bf16(b[2], b[3]); return w; }
__device__ __forceinline__ void unpack8(const u32x4 w, f32x4& a, f32x4& b) { a = (f32x4){bf_lo(w.x), bf_hi(w.x), bf_lo(w.y), bf_hi(w.y)}; b = (f32x4){bf_lo(w.z), bf_hi(w.z), bf_lo(w.w), bf_hi(w.w)}; }
__device__ __forceinline__ float wave_sum(float v) {
#pragma unroll
    for (int o = 1; o < 64; o <<= 1) v += __shfl_xor(v, o);
    return v;
}
__device__ __forceinline__ float sum16(const float* p) { const f32x4 a = *(const f32x4*)p, b = *(const f32x4*)(p + 4), c = *(const f32x4*)(p + 8), d = *(const f32x4*)(p + 12);
    return ((a[0] + a[1]) + (a[2] + a[3])) + ((b[0] + b[1]) + (b[2] + b[3])) + ((c[0] + c[1]) + (c[2] + c[3])) + ((d[0] + d[1]) + (d[2] + d[3])); }
__device__ __forceinline__ float rstd_from_parts(const float* ssp, int row) { return __builtin_amdgcn_rsqf(sum16(ssp + (size_t)row * 16) * (1.f / DM) + EPS); }

typedef f32x4 AccT[2][2][4][2];

struct EpiZ {
    static constexpr bool PERM = true, AFTER_DRAIN = false, TWOSEG = false;
    bf16_t* big;
    __device__ __forceinline__ void operator()(const AccT& acc, const Unit& u, int wr, int wc, int fr, int fq) const {
        const int pn = u.pn, row0 = u.pm * 256 + wr * 64 + fr;
        if (pn >= 12 && pn < 20) {
            bf16_t* O = big + 3 * TS + (pn - 12) * 128 + wc * 32 + 8 * fq;
#pragma unroll
            for (int ai = 0; ai < 2; ++ai)
#pragma unroll
                for (int m = 0; m < 4; ++m) { const int row = row0 + ai * 128 + m * 16;
                    const f32x4 v0 = acc[ai][0][m][0] * acc[ai][1][m][0], v1 = acc[ai][0][m][1] * acc[ai][1][m][1];
                    *(u32x4*)(O + (size_t)row * DM) = pack8(v0, v1); }
        } else {
            int tsel, cb, act;
            if (pn < 12) { tsel = pn >> 2; cb = (pn & 3) * 256; act = (tsel == 1) ? 1 : 0; } else { tsel = 4 + ((pn - 20) >> 2); cb = ((pn - 20) & 3) * 256; act = 2; }
            bf16_t* O = big + (size_t)tsel * TS + cb + wc * 32 + 8 * fq;
#pragma unroll
            for (int ai = 0; ai < 2; ++ai)
#pragma unroll
                for (int m = 0; m < 4; ++m) { const int row = row0 + ai * 128 + m * 16;
#pragma unroll
                    for (int bj = 0; bj < 2; ++bj) { f32x4 v0 = acc[ai][bj][m][0], v1 = acc[ai][bj][m][1];
                        if (act == 1) {
#pragma unroll
                            for (int j = 0; j < 4; ++j) { v0[j] = gelu_f(v0[j]); v1[j] = gelu_f(v1[j]); } }
                        else if (act == 2) {
#pragma unroll
                            for (int j = 0; j < 4; ++j) { v0[j] = sigmoid_f(v0[j]); v1[j] = sigmoid_f(v1[j]); } }
                        *(u32x4*)(O + (size_t)row * DM + bj * 128) = pack8(v0, v1); } }
        }
    }
};
struct EpiMerge {
    static constexpr bool PERM = true, AFTER_DRAIN = false, TWOSEG = true;
    const bf16_t* GA; const bf16_t* GB; bf16_t* O;
    __device__ __forceinline__ void operator()(AccT& acc, const Unit& u, int wr, int wc, int fr, int fq) const {
        const int row0 = u.pm * 256 + wr * 64 + fr, col0 = u.pn * 256 + wc * 32 + 8 * fq;
        if (u.seg == 0) {
#pragma unroll
            for (int ai = 0; ai < 2; ++ai)
#pragma unroll
                for (int m = 0; m < 4; ++m) { const size_t off = (size_t)(row0 + ai * 128 + m * 16) * DM + col0;
#pragma unroll
                    for (int bj = 0; bj < 2; ++bj) { f32x4 a0, a1, b0, b1; unpack8(*(const u32x4*)(GA + off + bj * 128), a0, a1); unpack8(*(const u32x4*)(GB + off + bj * 128), b0, b1);
#pragma unroll
                        for (int j = 0; j < 4; ++j) { acc[ai][bj][m][0][j] *= a0[j] * __builtin_amdgcn_rcpf(fmaxf(b0[j], 1e-20f)); acc[ai][bj][m][1][j] *= a1[j] * __builtin_amdgcn_rcpf(fmaxf(b1[j], 1e-20f)); } } }
        } else {
#pragma unroll
            for (int ai = 0; ai < 2; ++ai)
#pragma unroll
                for (int m = 0; m < 4; ++m) { const size_t off = (size_t)(row0 + ai * 128 + m * 16) * DM + col0;
#pragma unroll
                    for (int bj = 0; bj < 2; ++bj) { f32x4 b0, b1; unpack8(*(const u32x4*)(GB + off + bj * 128), b0, b1);
                        *(u32x4*)(O + off + bj * 128) = pack8(acc[ai][bj][m][0] * b0, acc[ai][bj][m][1] * b1); } }
        }
    }
};
template <bool SS, bool SCALE> struct EpiResB {
    static constexpr bool PERM = true, AFTER_DRAIN = false, TWOSEG = false;
    const bf16_t* R; const float* rscale; bf16_t* O; float* ssp;
    __device__ __forceinline__ void operator()(const AccT& acc, const Unit& u, int wr, int wc, int fr, int fq) const {
        const int row0 = u.pm * 256 + wr * 64 + fr, col0 = u.pn * 256 + wc * 32 + 8 * fq;
#pragma unroll
        for (int ai = 0; ai < 2; ++ai)
#pragma unroll
            for (int m = 0; m < 4; ++m) { const int row = row0 + ai * 128 + m * 16; const size_t off = (size_t)row * DM + col0; float ss = 0.f; const float sc = SCALE ? rscale[row] : 1.f;
#pragma unroll
                for (int bj = 0; bj < 2; ++bj) { f32x4 r0, r1; unpack8(*(const u32x4*)(R + off + bj * 128), r0, r1);
                    const f32x4 v0 = r0 * sc + acc[ai][bj][m][0], v1 = r1 * sc + acc[ai][bj][m][1];
                    *(u32x4*)(O + off + bj * 128) = pack8(v0, v1);
                    if (SS) ss += ((v0[0] * v0[0] + v0[1] * v0[1]) + (v0[2] * v0[2] + v0[3] * v0[3])) + ((v1[0] * v1[0] + v1[1] * v1[1]) + (v1[2] * v1[2] + v1[3] * v1[3])); }
                if (SS) { ss += __shfl_xor(ss, 16); ss += __shfl_xor(ss, 32); if (fq == 0) ssp[(size_t)row * 16 + u.pn * 4 + wc] = ss; } }
    }
};
#define DPP_F(v, ctrl) __int_as_float(__builtin_amdgcn_update_dpp(0, __float_as_int(v), (ctrl), 0xf, 0xf, true))
struct EpiAct {
    static constexpr bool PERM = true, AFTER_DRAIN = false, TWOSEG = false;
    bf16_t* ACT; const float* ssp; const float* cw; const float* cb; float* halo; LAS float* ex;
    __device__ __forceinline__ void operator()(AccT& acc, const Unit& u, int wr, int wc, int fr, int fq) const {
        const int row0 = u.pm * 256 + wr * 64 + fr, colA = u.pn * 128 + wc * 32 + 8 * fq, lc = wc * 32 + 8 * fq;
        LAS float* rsd = ex + 2048; LAS float* wts = ex + 2048 + 256;
        {
            const int t = (wr * 4 + wc) * 64 + fq * 16 + fr;
            if (t < 256) { const int bj = t >> 7, k = (t >> 5) & 3, c4 = (t & 31) * 4;
                const f32x4 v = (k < 3) ? *(const f32x4*)(cw + k * 2 * DFF + bj * DFF + u.pn * 128 + c4) : *(const f32x4*)(cb + bj * DFF + u.pn * 128 + c4);
                *(LAS f32x4*)(wts + (bj * 4 + k) * 128 + c4) = v; }
            else rsd[t - 256] = rstd_from_parts(ssp, u.pm * 256 + (t - 256));
        }
        asm volatile("s_waitcnt lgkmcnt(0)" ::: "memory"); __builtin_amdgcn_s_barrier(); asm volatile("" ::: "memory");
#pragma unroll
        for (int ai = 0; ai < 2; ++ai)
#pragma unroll
            for (int m = 0; m < 4; ++m) { const float rs = rsd[ai * 128 + wr * 64 + m * 16 + fr];
#pragma unroll
                for (int bj = 0; bj < 2; ++bj) { acc[ai][bj][m][0] *= rs; acc[ai][bj][m][1] *= rs; } }
        const int wv = wr * 4 + wc;
        if (fr >= 14) {
#pragma unroll
            for (int ai = 0; ai < 2; ++ai) { LAS float* e = ex + ((((wv * 2 + ai) * 2 + (fr - 14)) * 4 + fq) * 16);
#pragma unroll
                for (int bj = 0; bj < 2; ++bj) { *(LAS f32x4*)(e + bj * 8) = acc[ai][bj][3][0]; *(LAS f32x4*)(e + bj * 8 + 4) = acc[ai][bj][3][1]; } }
            if (wr == 1) { float* h = halo + ((size_t)u.pm * 4 + 2 + (fr - 14)) * (2 * DFF) + u.pn * 256 + lc;
#pragma unroll
                for (int bj = 0; bj < 2; ++bj) { *(f32x4*)(h + bj * 128) = acc[1][bj][3][0]; *(f32x4*)(h + bj * 128 + 4) = acc[1][bj][3][1]; } }
        }
        if (wr == 0 && fr < 2) { float* h = halo + ((size_t)u.pm * 4 + fr) * (2 * DFF) + u.pn * 256 + lc;
#pragma unroll
            for (int bj = 0; bj < 2; ++bj) { *(f32x4*)(h + bj * 128) = acc[0][bj][0][0]; *(f32x4*)(h + bj * 128 + 4) = acc[0][bj][0][1]; } }
        asm volatile("s_waitcnt lgkmcnt(0)" ::: "memory"); __builtin_amdgcn_s_barrier(); asm volatile("" ::: "memory");
        float tok = 0.f;
#pragma unroll
        for (int ai = 0; ai < 2; ++ai) {
            f32x4 V[2][2];
            if (ai == 0 && wr == 0) {
#pragma unroll
                for (int bj = 0; bj < 2; ++bj) { V[bj][0] = (f32x4){0.f, 0.f, 0.f, 0.f}; V[bj][1] = V[bj][0]; }
            } else {
                const int sw = (wr == 1) ? wc : 4 + wc, sai = (wr == 1) ? ai : ai - 1;
                const LAS float* e = ex + ((((sw * 2 + sai) * 2 + (fr >= 14 ? fr - 14 : 0)) * 4 + fq) * 16);
#pragma unroll
                for (int bj = 0; bj < 2; ++bj) { V[bj][0] = *(const LAS f32x4*)(e + bj * 8); V[bj][1] = *(const LAS f32x4*)(e + bj * 8 + 4); }
            }
#pragma unroll
            for (int bj = 0; bj < 2; ++bj)
#pragma unroll
                for (int n = 0; n < 2; ++n) {
                    int wo = (bj * 4) * 128 + lc + 4 * n; asm volatile("" : "+v"(wo), "+v"(tok));
                    const f32x4 w0 = *(const LAS f32x4*)(wts + wo), w1 = *(const LAS f32x4*)(wts + wo + 128), w2 = *(const LAS f32x4*)(wts + wo + 256), bb = *(const LAS f32x4*)(wts + wo + 384);
                    const f32x4 zz = {0.f, 0.f, 0.f, 0.f};
                    const f32x4 w1z = (fr == 0) ? w1 : zz, w0z = (fr < 2) ? w0 : zz;
#pragma unroll
                    for (int m = 3; m >= 0; --m) {
                        if (m > 0) asm volatile("" : "+v"(tok), "+v"(acc[ai][bj][m][n]), "+v"(acc[ai][bj][m - 1][n])); else asm volatile("" : "+v"(tok), "+v"(acc[ai][bj][m][n]), "+v"(V[bj][n]));
                        const f32x4 cur = acc[ai][bj][m][n]; const f32x4 prv = (m > 0) ? acc[ai][bj][m - 1][n] : V[bj][n]; f32x4 o;
#pragma unroll
                        for (int j = 0; j < 4; ++j) o[j] = bb[j] + w2[j] * cur[j] + w1[j] * DPP_F(cur[j], 0x111) + w0[j] * DPP_F(cur[j], 0x112) + w1z[j] * DPP_F(prv[j], 0x121) + w0z[j] * DPP_F(prv[j], 0x122);
                        acc[ai][bj][m][n] = o; tok = o[3]; }
                }
#pragma unroll
            for (int m = 0; m < 4; ++m) { const int row = row0 + ai * 128 + m * 16; f32x4 a0, a1;
                asm volatile("" : "+v"(tok), "+v"(acc[ai][0][m][0]), "+v"(acc[ai][0][m][1]));
#pragma unroll
                for (int j = 0; j < 4; ++j) { a0[j] = gelu_f(acc[ai][0][m][0][j]) * acc[ai][1][m][0][j]; a1[j] = gelu_f(acc[ai][0][m][1][j]) * acc[ai][1][m][1][j]; }
                const u32x4 pk = pack8(a0, a1); tok = __uint_as_float(pk.x);
                *(u32x4*)(ACT + (size_t)row * DFF + colA) = pk; }
        }
    }
};
struct EpiE0 {
    static constexpr bool PERM = true, AFTER_DRAIN = false, TWOSEG = false;
    bf16_t* E0; float* ssp;
    __device__ __forceinline__ void operator()(const AccT& acc, const Unit& u, int wr, int wc, int fr, int fq) const {
        const int row0 = u.pm * 256 + wr * 64 + fr, col0 = u.pn * 256 + wc * 32 + 8 * fq;
#pragma unroll
        for (int ai = 0; ai < 2; ++ai)
#pragma unroll
            for (int m = 0; m < 4; ++m) { const int row = row0 + ai * 128 + m * 16; float ss = 0.f;
#pragma unroll
                for (int bj = 0; bj < 2; ++bj) { const f32x4 v0 = acc[ai][bj][m][0], v1 = acc[ai][bj][m][1];
                    *(u32x4*)(E0 + (size_t)row * DM + col0 + bj * 128) = pack8(v0, v1);
                    ss += ((v0[0] * v0[0] + v0[1] * v0[1]) + (v0[2] * v0[2] + v0[3] * v0[3])) + ((v1[0] * v1[0] + v1[1] * v1[1]) + (v1[2] * v1[2] + v1[3] * v1[3])); }
                ss += __shfl_xor(ss, 16); ss += __shfl_xor(ss, 32); if (fq == 0) ssp[(size_t)row * 16 + u.pn * 4 + wc] = ss; }
    }
};
struct EpiFin {
    static constexpr bool PERM = true, AFTER_DRAIN = false, TWOSEG = false;
    const bf16_t* X; float* OUT; const bf16_t* E0; const float* ss3p; const float* gple; const float* gfin; float* ss4; unsigned* cnt;
    __device__ __forceinline__ void operator()(AccT& acc, const Unit& u, int wr, int wc, int fr, int fq) const {
        const int row0 = u.pm * 256 + wr * 64 + fr, col0 = u.pn * 256 + wc * 32 + 8 * fq;
        {
            f32x4 gp[2][2];
#pragma unroll
            for (int bj = 0; bj < 2; ++bj) { gp[bj][0] = *(const f32x4*)(gple + col0 + bj * 128); gp[bj][1] = *(const f32x4*)(gple + col0 + bj * 128 + 4); }
#pragma unroll
            for (int ai = 0; ai < 2; ++ai)
#pragma unroll
                for (int m = 0; m < 4; ++m) { const int row = row0 + ai * 128 + m * 16; const float rs = rstd_from_parts(ss3p, row); float ss = 0.f; const size_t off = (size_t)row * DM + col0;
#pragma unroll
                    for (int bj = 0; bj < 2; ++bj) { f32x4 e0, e1; unpack8(*(const u32x4*)(E0 + off + bj * 128), e0, e1);
                        f32x4 x0, x1; unpack8(*(const u32x4*)(X + off + bj * 128), x0, x1);
                        const f32x4 a0 = acc[ai][bj][m][0], a1 = acc[ai][bj][m][1];
#pragma unroll
                        for (int j = 0; j < 4; ++j) { x0[j] += sigmoid_f(a0[j]) * (e0[j] * rs * gp[bj][0][j]); x1[j] += sigmoid_f(a1[j]) * (e1[j] * rs * gp[bj][1][j]); }
                        acc[ai][bj][m][0] = x0; acc[ai][bj][m][1] = x1;
                        ss += ((x0[0] * x0[0] + x0[1] * x0[1]) + (x0[2] * x0[2] + x0[3] * x0[3])) + ((x1[0] * x1[0] + x1[1] * x1[1]) + (x1[2] * x1[2] + x1[3] * x1[3])); }
                    ss += __shfl_xor(ss, 16); ss += __shfl_xor(ss, 32);
                    if (fq == 0) __hip_atomic_fetch_add(ss4 + row, ss, __ATOMIC_RELAXED, __HIP_MEMORY_SCOPE_AGENT);
                    if (m & 1) __builtin_amdgcn_sched_barrier(0); }
        }
        asm volatile("s_waitcnt vmcnt(0)" ::: "memory");
        unsigned* c = cnt + 64 * u.pm;
        if (fr == 0 && fq == 0) __hip_atomic_fetch_add(c, 1u, __ATOMIC_RELAXED, __HIP_MEMORY_SCOPE_AGENT);
        { unsigned spins = 0;
          while ((unsigned)__builtin_amdgcn_readfirstlane(__hip_atomic_load(c, __ATOMIC_RELAXED, __HIP_MEMORY_SCOPE_AGENT)) < 32u) { __builtin_amdgcn_s_sleep(2); if (++spins > (1u << 22)) break; } }
        asm volatile("" ::: "memory");
        f32x4 gf[2][2];
#pragma unroll
        for (int bj = 0; bj < 2; ++bj) { gf[bj][0] = *(const f32x4*)(gfin + col0 + bj * 128); gf[bj][1] = *(const f32x4*)(gfin + col0 + bj * 128 + 4); }
#pragma unroll
        for (int ai = 0; ai < 2; ++ai)
#pragma unroll
            for (int m = 0; m < 4; ++m) { const int row = row0 + ai * 128 + m * 16; const size_t off = (size_t)row * DM + col0;
                const float rs = __builtin_amdgcn_rsqf(__hip_atomic_load(ss4 + row, __ATOMIC_RELAXED, __HIP_MEMORY_SCOPE_AGENT) * (1.f / DM) + EPS);
#pragma unroll
                for (int bj = 0; bj < 2; ++bj) { *(f32x4*)(OUT + off + bj * 128) = acc[ai][bj][m][0] * rs * gf[bj][0]; *(f32x4*)(OUT + off + bj * 128 + 4) = acc[ai][bj][m][1] * rs * gf[bj][1]; } }
    }
};

#define LDS_WAIT() asm volatile("s_waitcnt lgkmcnt(0)" ::: "memory")
__device__ __forceinline__ void transpose_item(const float* W, int K, int N, int srcn0, const float* gs, bf16_t* WT, int dstn0, int k0, LAS float* scr, int lane) {
    float tv[32];
#pragma unroll
    for (int i = 0; i < 32; ++i) tv[i] = W[(size_t)(k0 + 2 * i + (lane >> 5)) * N + srcn0 + (lane & 31)];
    if (gs) {
#pragma unroll
        for (int i = 0; i < 32; ++i) tv[i] *= gs[k0 + 2 * i + (lane >> 5)]; }
#pragma unroll
    for (int i = 0; i < 32; ++i) scr[(2 * i + (lane >> 5)) * 33 + (lane & 31)] = tv[i];
    LDS_WAIT(); asm volatile("" ::: "memory");
    const int c = lane & 7;
#pragma unroll
    for (int j = 0; j < 4; ++j) { const int n = (lane >> 3) + 8 * j; const LAS float* s = scr + (8 * c) * 33 + n;
        u32x4 o; o.x = cvt_pk_bf16(s[0 * 33], s[1 * 33]); o.y = cvt_pk_bf16(s[2 * 33], s[3 * 33]); o.z = cvt_pk_bf16(s[4 * 33], s[5 * 33]); o.w = cvt_pk_bf16(s[6 * 33], s[7 * 33]);
        *(u32x4*)(WT + (size_t)(dstn0 + n) * K + k0 + 8 * c) = o; }
    LDS_WAIT(); asm volatile("" ::: "memory");
}
__device__ __forceinline__ int win_src(int n0) {
    if (n0 < 3072 || n0 >= 5120) return n0;
    const int w = n0 - 3072, q = w >> 8, r = w & 255;
    return (r < 128) ? 3072 + 128 * q + r : 4096 + 128 * q + (r - 128);
}
__device__ __forceinline__ int up_src(int n0) { return ((n0 & 255) >> 7) * DFF + 128 * (n0 >> 8) + (n0 & 127); }
__device__ __forceinline__ void p0_prologue(LAS unsigned char* lds, const Params& P, int G, int bid) {
    int tid = threadIdx.x; asm volatile("" : "+v"(tid)); const int lane = tid & 63, wave = tid >> 6;
    LAS float* scr = (LAS float*)(lds + wave * 16384);
    unsigned char* ws = P.ws;
    const int gw = bid * 8 + wave, NGW = G * 8;
    constexpr int I_IN = 16 * 224, I_UP = 16 * 192, I_DN = 48 * 32, I_SQ = 16 * 32, I_PLE = 4 * 32, I_RG = 128;
    constexpr int NITEMS = I_IN + I_UP + I_DN + 4 * I_SQ + I_PLE + I_RG;
    for (int it = gw; it < NITEMS; it += NGW) {
        int r = it;
        if (r < I_IN) { const int kb = r / 224, nb = r % 224; transpose_item(P.w_in, DM, DIN, win_src(nb * 32), P.g_mix, (bf16_t*)(ws + WS_WIN), nb * 32, kb * 64, scr, lane); continue; } r -= I_IN;
        if (r < I_UP) { const int kb = r / 192, nb = r % 192; transpose_item(P.w_up, DM, 2 * DFF, up_src(nb * 32), P.g_ffn, (bf16_t*)(ws + WS_WUP), nb * 32, kb * 64, scr, lane); continue; } r -= I_UP;
        if (r < I_DN) { const int kb = r / 32, nb = r % 32; transpose_item(P.w_down, DFF, DM, nb * 32, nullptr, (bf16_t*)(ws + WS_WDOWN), nb * 32, kb * 64, scr, lane); continue; } r -= I_DN;
        if (r < 4 * I_SQ) { const int w = r / I_SQ, rr = r % I_SQ, kb = rr / 32, nb = rr % 32;
            const float* W = (w == 0) ? P.w_proj_a : (w == 1) ? P.w_proj_b : (w == 2) ? P.w_out : P.w_ple_gate;
            bf16_t* WT = (bf16_t*)(ws + ((w == 0) ? WS_WPA : (w == 1) ? WS_WPB : (w == 2) ? WS_WOUT : WS_WGATE));
            transpose_item(W, DM, DM, nb * 32, nullptr, WT, nb * 32, kb * 64, scr, lane); continue; } r -= 4 * I_SQ;
        if (r < I_PLE) { const int kb = r / 32, nb = r % 32; transpose_item(P.w_ple_proj, DPLE, DM, nb * 32, nullptr, (bf16_t*)(ws + WS_WPLE), nb * 32, kb * 64, scr, lane); continue; } r -= I_PLE;
        { const int g = r >> 6, h = (r >> 3) & 7, sub = r & 7, kb = sub >> 2, nb = sub & 3;
          const float* W = (g ? P.w_rg_x : P.w_rg_a) + (size_t)h * 128 * 128;
          transpose_item(W, 128, 128, nb * 32, nullptr, (bf16_t*)(ws + WS_WRG) + (size_t)(g * 8 + h) * 128 * 128, nb * 32, kb * 64, scr, lane); }
    }
    bf16_t* XB = (bf16_t*)(ws + WS_XB); float* rnorm = (float*)(ws + WS_RSTD1);
    for (int m0 = 2 * gw; m0 < T; m0 += 2 * NGW) {
        f32x4 v[2][4]; float s[2];
#pragma unroll
        for (int rr = 0; rr < 2; ++rr) { const f32x4* xr = (const f32x4*)(P.x + (size_t)(m0 + rr) * DM) + lane;
#pragma unroll
            for (int j = 0; j < 4; ++j) v[rr][j] = xr[64 * j]; }
#pragma unroll
        for (int rr = 0; rr < 2; ++rr) { float a = 0.f;
#pragma unroll
            for (int j = 0; j < 4; ++j) a += (v[rr][j][0] * v[rr][j][0] + v[rr][j][1] * v[rr][j][1]) + (v[rr][j][2] * v[rr][j][2] + v[rr][j][3] * v[rr][j][3]);
            s[rr] = wave_sum(a); }
#pragma unroll
        for (int rr = 0; rr < 2; ++rr) { u32x2* o8 = (u32x2*)(XB + (size_t)(m0 + rr) * DM) + lane; const float rs = __builtin_amdgcn_rsqf(s[rr] * (1.f / DM) + EPS);
            if (lane == 0) rnorm[m0 + rr] = __builtin_amdgcn_sqrtf(s[rr] * (1.f / DM) + EPS);
#pragma unroll
            for (int j = 0; j < 4; ++j) { u32x2 w; w.x = cvt_pk_bf16(v[rr][j][0] * rs, v[rr][j][1] * rs); w.y = cvt_pk_bf16(v[rr][j][2] * rs, v[rr][j][3] * rs); o8[64 * j] = w; } }
    }
    { float* ss4 = (float*)(ws + WS_SS4P); for (int i = bid * NTHREADS + tid; i < T; i += G * NTHREADS) ss4[i] = 0.f; }
    bf16_t* PB = (bf16_t*)(ws + WS_PB);
    for (size_t i = (size_t)bid * NTHREADS + tid; i < (size_t)T * DPLE / 8; i += (size_t)G * NTHREADS) {
        const f32x4 a = *(const f32x4*)(P.p + i * 8), b = *(const f32x4*)(P.p + i * 8 + 4);
        *(u32x4*)(PB + i * 8) = pack8(a, b);
    }
}

constexpr int RG_ROWB = 272, RG_TILEB = 256 * RG_ROWB;
__device__ __forceinline__ void rg_build_tile(const bf16_t* xrb  , int s, LAS unsigned char* tile, const LAS float* cw, int o, int rg) {
    const bool first = (s == 0 && rg == 0);
    const GAS bf16_t* p = (const GAS bf16_t*)xrb + (size_t)((first ? 0 : s * 256 + 8 * rg - 3) * DM + 8 * o);
    u32x4 raw[11];
#pragma unroll
    for (int i = 0; i < 11; ++i) { raw[i] = *(const GAS u32x4*)p; p += (first && i < 3) ? 0 : DM; asm volatile("" : "+v"(p)); }
    if (first) { raw[0] = (u32x4){0u, 0u, 0u, 0u}; raw[1] = raw[0]; raw[2] = raw[0]; }
#pragma unroll
    for (int c = 0; c < 2; ++c) {
        f32x4 w[5];
#pragma unroll
        for (int k = 0; k < 5; ++k) w[k] = *(const LAS f32x4*)(cw + k * 128 + 8 * o + 4 * c);
        f32x4 u[4];
#pragma unroll
        for (int i = 0; i < 3; ++i) u[i] = (f32x4){bf_lo(raw[i][2 * c]), bf_hi(raw[i][2 * c]), bf_lo(raw[i][2 * c + 1]), bf_hi(raw[i][2 * c + 1])};
#pragma unroll
        for (int r = 0; r < 8; ++r) {
            u[(r + 3) & 3] = (f32x4){bf_lo(raw[r + 3][2 * c]), bf_hi(raw[r + 3][2 * c]), bf_lo(raw[r + 3][2 * c + 1]), bf_hi(raw[r + 3][2 * c + 1])};
            f32x4 y = w[4];
#pragma unroll
            for (int k = 0; k < 4; ++k) y += w[k] * u[(r + k) & 3];
            u32x2 pk; pk.x = cvt_pk_bf16(y[0], y[1]); pk.y = cvt_pk_bf16(y[2], y[3]);
            *(LAS u32x2*)(tile + (8 * rg + r) * RG_ROWB + o * 16 + c * 8) = pk;
        }
        __builtin_amdgcn_sched_barrier(0);
    }
}
__device__ __forceinline__ void p2_rglru(LAS unsigned char* lds, const Params& P, const bf16_t* XR, const bf16_t* GIN, bf16_t* YO, const bf16_t* WRG, bf16_t* CB, const bf16_t* CCX, int G, int bid) {
    int tid = threadIdx.x; asm volatile("" : "+v"(tid)); const int lane = tid & 63, wid = __builtin_amdgcn_readfirstlane(tid >> 6), fr = lane & 15, fq = lane >> 4, cgi = wid & 1, tq = wid >> 1;
    const int o = tid & 15, rg = tid >> 4;
    LAS float* summ = (LAS float*)(lds + 2 * RG_TILEB);
    LAS float* cw = (LAS float*)(lds + 2 * RG_TILEB + 2048);
    for (int item = bid; item < 256; item += G) {
        const int grp = (G == 256) ? ((item >> 5) + 8 * (item & 7)) : (item >> 2), qq = (G == 256) ? ((item >> 3) & 3) : (item & 3);
        const int b = grp >> 3, h = grp & 7, q = qq, chb = h * 128, cl = 32 * q + 16 * cgi + fr, cho = chb + cl;
        const size_t rowbase = (size_t)b * SEQ;
        const bf16_t* xrb = XR + rowbase * DM + chb;
        const GAS bf16_t* gib = (const GAS bf16_t*)GIN + rowbase * DM; GAS bf16_t* gyb = (GAS bf16_t*)YO + rowbase * DM;
        __syncthreads();
        if (tid < 128) {
#pragma unroll
            for (int k = 0; k < 4; ++k) cw[k * 128 + tid] = P.rnn_conv_w[k * DM + chb + tid];
            cw[4 * 128 + tid] = P.rnn_conv_b[chb + tid]; }
        const GAS bf16_t* wrow = (const GAS bf16_t*)WRG + ((size_t)h * 128 + cl) * 128 + 8 * fq;
        const int c4 = 32 * q + 16 * cgi + 4 * fq;
        const f32x4 ba = *(const f32x4*)(P.b_rg_a + chb + c4), bx = *(const f32x4*)(P.b_rg_x + chb + c4);
        f32x4 sp16; { const f32x4 lam = *(const f32x4*)(P.lru_lambda + chb + c4);
#pragma unroll
            for (int j = 0; j < 4; ++j) sp16[j] = 16.f * log1pf(expf(-lam[j])); }
        f32x4 Hrun = {0.f, 0.f, 0.f, 0.f};
        bf16x8 Ba[4], Bx[4];
#pragma unroll
        for (int kk = 0; kk < 4; ++kk) { Ba[kk] = *(const GAS bf16x8*)(wrow + 32 * kk); Bx[kk] = *(const GAS bf16x8*)(wrow + 8 * 128 * 128 + 32 * kk); }
        __syncthreads();
        rg_build_tile(xrb, 0, lds, cw, o, rg);
        __syncthreads();
        for (int s = 0; s < 16; ++s) {
            LAS unsigned char* tl = lds + (s & 1) * RG_TILEB;
            const bool has_next = (s + 1 < 16);
            unsigned goff = (unsigned)((s * 256 + 64 * tq + fr) * DM + chb + c4); asm volatile("" : "+v"(goff));
            u32x2 gvp[4];
#pragma unroll
            for (int m = 0; m < 4; ++m) gvp[m] = *(const GAS u32x2*)(gib + goff + (unsigned)(16 * m * DM));
            __builtin_amdgcn_sched_barrier(0);
            f32x4 aa[4], ax[4];
#pragma unroll
            for (int m = 0; m < 4; ++m) { aa[m] = (f32x4){0.f, 0.f, 0.f, 0.f}; ax[m] = (f32x4){0.f, 0.f, 0.f, 0.f}; }
#pragma unroll
            for (int m = 0; m < 4; ++m)
#pragma unroll
                for (int kk = 0; kk < 4; ++kk) { const bf16x8 A = *(const LAS bf16x8*)(tl + (64 * tq + 16 * m + fr) * RG_ROWB + (32 * kk + 8 * fq) * 2);
                    aa[m] = __builtin_amdgcn_mfma_f32_16x16x32_bf16(Ba[kk], A, aa[m], 0, 0, 0); ax[m] = __builtin_amdgcn_mfma_f32_16x16x32_bf16(Bx[kk], A, ax[m], 0, 0, 0); }
            __builtin_amdgcn_sched_barrier(0);
            f32x4 hl[4], pl[4]; f32x4 Pc = {1.f, 1.f, 1.f, 1.f}, Hc = {0.f, 0.f, 0.f, 0.f};
#define RG_SHR_F(v, d, oldv) __int_as_float(__builtin_amdgcn_update_dpp(__float_as_int(oldv), __float_as_int(v), 0x110 + (d), 0xf, 0xf, false))
#define RG_B15_F(v) __int_as_float(__builtin_amdgcn_ds_swizzle(__float_as_int(v), 0x1F0))
#pragma unroll
            for (int m = 0; m < 4; ++m) {
                const u32x2 xw = *(const LAS u32x2*)(tl + (64 * tq + 16 * m + fr) * RG_ROWB + c4 * 2);
                const f32x4 xv = {bf_lo(xw.x), bf_hi(xw.x), bf_lo(xw.y), bf_hi(xw.y)};
                f32x4 Pv, Hv;
#pragma unroll
                for (int j = 0; j < 4; ++j) {
                    const float r = sigmoid_f(aa[m][j] + ba[j]), ig = sigmoid_f(ax[m][j] + bx[j]);
                    const float y2 = -sp16[j] * r;
                    const float a = __builtin_amdgcn_exp2f(y2 * 0.7213475204444817f);
                    const float ser = -y2 * (1.f + y2 * 0.5f * (1.f + y2 * (1.f / 3.f) * (1.f + y2 * 0.25f * (1.f + y2 * 0.2f * (1.f + y2 * (1.f / 6.f))))));
                    const float em = (y2 > -0.5f) ? ser : 1.f - a * a;
                    Pv[j] = a; Hv[j] = __builtin_amdgcn_sqrtf(em) * ig * xv[j];
                }
#pragma unroll
                for (int j = 0; j < 4; ++j) {
                    float Pj = Pv[j], Hj = Hv[j];
                    { const float Pp = RG_SHR_F(Pj, 1, 1.f), Hp = RG_SHR_F(Hj, 1, 0.f); Hj = Pj * Hp + Hj; Pj = Pp * Pj; }
                    { const float Pp = RG_SHR_F(Pj, 2, 1.f), Hp = RG_SHR_F(Hj, 2, 0.f); Hj = Pj * Hp + Hj; Pj = Pp * Pj; }
                    { const float Pp = RG_SHR_F(Pj, 4, 1.f), Hp = RG_SHR_F(Hj, 4, 0.f); Hj = Pj * Hp + Hj; Pj = Pp * Pj; }
                    { const float Pp = RG_SHR_F(Pj, 8, 1.f), Hp = RG_SHR_F(Hj, 8, 0.f); Hj = Pj * Hp + Hj; Pj = Pp * Pj; }
                    const float Pt = RG_B15_F(Pj), Ht = RG_B15_F(Hj);
                    hl[m][j] = Pj * Hc[j] + Hj; pl[m][j] = Pc[j] * Pj;
                    Hc[j] = Pt * Hc[j] + Ht; Pc[j] = Pc[j] * Pt;
                }
                __builtin_amdgcn_sched_barrier(0);
            }
            LAS float* sm = summ + (s & 1) * 256;
            if (fr == 0) { LAS float* d = sm + ((tq * 2 + cgi) * 16 + 4 * fq) * 2;
                *(LAS f32x4*)d = (f32x4){Pc[0], Hc[0], Pc[1], Hc[1]}; *(LAS f32x4*)(d + 4) = (f32x4){Pc[2], Hc[2], Pc[3], Hc[3]}; }
            __builtin_amdgcn_sched_barrier(0);
            if (has_next) rg_build_tile(xrb, s + 1, lds + ((s + 1) & 1) * RG_TILEB, cw, o, rg);
            u32x4 sc_c[4], sc_b[2]; const int sc_r0 = item * 128 + 8 * s + 2 * (tid >> 7), sc_o = tid & 127;
            if (CB) { const bool seq0 = (sc_r0 & (SEQ - 1)) == 0;
#pragma unroll
                for (int i = 0; i < 4; ++i) { const int rr = (seq0 && i < 2) ? sc_r0 : sc_r0 - 2 + i; sc_c[i] = *(const GAS u32x4*)((const GAS bf16_t*)CCX + (size_t)rr * DM + 8 * sc_o); if (seq0 && i < 2) sc_c[i] = (u32x4){0u, 0u, 0u, 0u}; }
#pragma unroll
                for (int i = 0; i < 2; ++i) sc_b[i] = *(const GAS u32x4*)((const GAS bf16_t*)CB + (size_t)(sc_r0 + i) * DM + 8 * sc_o); }
            __syncthreads();
            f32x4 Hs = Hrun, Hall = Hrun;
#pragma unroll
            for (int t = 0; t < 4; ++t) { const LAS float* d = sm + ((t * 2 + cgi) * 16 + 4 * fq) * 2; const f32x4 w0 = *(const LAS f32x4*)d, w1 = *(const LAS f32x4*)(d + 4);
                Hall[0] = w0[0] * Hall[0] + w0[1]; Hall[1] = w0[2] * Hall[1] + w0[3]; Hall[2] = w1[0] * Hall[2] + w1[1]; Hall[3] = w1[2] * Hall[3] + w1[3];
                if (t < tq) Hs = Hall; }
            Hrun = Hall;
#pragma unroll
            for (int m = 0; m < 4; ++m) { const f32x4 hv = hl[m] + pl[m] * Hs; const f32x4 gg = {bf_lo(gvp[m].x), bf_hi(gvp[m].x), bf_lo(gvp[m].y), bf_hi(gvp[m].y)};
                u32x2 pk; pk.x = cvt_pk_bf16(hv[0] * gg[0], hv[1] * gg[1]); pk.y = cvt_pk_bf16(hv[2] * gg[2], hv[3] * gg[3]);
                *(GAS u32x2*)(gyb + goff + (unsigned)(16 * m * DM)) = pk; }
            if (CB) {
                f32x4 w[3][2];
#pragma unroll
                for (int k = 0; k < 3; ++k) { w[k][0] = *(const f32x4*)(P.sc_conv_w + k * DM + 8 * sc_o); w[k][1] = *(const f32x4*)(P.sc_conv_w + k * DM + 8 * sc_o + 4); }
                f32x4 c[4][2];
#pragma unroll
                for (int i = 0; i < 4; ++i) unpack8(sc_c[i], c[i][0], c[i][1]);
#pragma unroll
                for (int i = 0; i < 2; ++i) { f32x4 b0, b1; unpack8(sc_b[i], b0, b1);
                    const f32x4 y0 = b0 * (w[0][0] * c[i][0] + w[1][0] * c[i + 1][0] + w[2][0] * c[i + 2][0]), y1 = b1 * (w[0][1] * c[i][1] + w[1][1] * c[i + 1][1] + w[2][1] * c[i + 2][1]);
                    *(GAS u32x4*)((GAS bf16_t*)CB + (size_t)(sc_r0 + i) * DM + 8 * sc_o) = pack8(y0, y1); }
            }
        }
    }
}
__device__ __forceinline__ void p2_shortconv(const Params& P, bf16_t* CB, const bf16_t* CCX, int G, int bid) {
    const int nth = G * NTHREADS; int tid = threadIdx.x; asm volatile("" : "+v"(tid));
    for (int it = bid * NTHREADS + tid; it < (T / 16) * 128; it += nth) {
        const int o = it & 127, row0 = (it >> 7) * 16;
        f32x4 w[3][2];
#pragma unroll
        for (int k = 0; k < 3; ++k) { w[k][0] = *(const f32x4*)(P.sc_conv_w + k * DM + 8 * o); w[k][1] = *(const f32x4*)(P.sc_conv_w + k * DM + 8 * o + 4); }
        f32x4 p2a = {0.f, 0.f, 0.f, 0.f}, p2b = p2a, p1a = p2a, p1b = p2a;
        if ((row0 & (SEQ - 1)) != 0) { unpack8(*(const u32x4*)(CCX + (size_t)(row0 - 2) * DM + 8 * o), p2a, p2b); unpack8(*(const u32x4*)(CCX + (size_t)(row0 - 1) * DM + 8 * o), p1a, p1b); }
#pragma unroll 4
        for (int r = 0; r < 16; ++r) { const size_t off = (size_t)(row0 + r) * DM + 8 * o;
            f32x4 c0a, c0b, ba, bb; unpack8(*(const u32x4*)(CCX + off), c0a, c0b); unpack8(*(const u32x4*)(CB + off), ba, bb);
            const f32x4 ya = ba * (w[0][0] * p2a + w[1][0] * p1a + w[2][0] * c0a), yb = bb * (w[0][1] * p2b + w[1][1] * p1b + w[2][1] * c0b);
            *(u32x4*)(CB + off) = pack8(ya, yb);
            p2a = p1a; p2b = p1b; p1a = c0a; p1b = c0b; }
    }
}
__device__ __forceinline__ void p6_fixup(const Params& P, const float* halo, bf16_t* ACT, int G, int bid) {
    const int nth = G * NTHREADS; int tid = threadIdx.x; asm volatile("" : "+v"(tid));
    for (int it = bid * NTHREADS + tid; it < (T / 256) * DFF; it += nth) {
        const int pm = it / DFF, c = it % DFF;
        if ((pm & 15) == 0) continue;
        const int cg_ = 256 * (c >> 7) + (c & 127), cv = cg_ + 128;
        const float* hc = halo + (size_t)pm * 4 * (2 * DFF); const float* hp = hc - 4 * (2 * DFF);
        const float g254 = hp[2 * (2 * DFF) + cg_], g255 = hp[3 * (2 * DFF) + cg_], g0 = hc[cg_], g1 = hc[(2 * DFF) + cg_];
        const float v254 = hp[2 * (2 * DFF) + cv], v255 = hp[3 * (2 * DFF) + cv], v0 = hc[cv], v1 = hc[(2 * DFF) + cv];
        const float wg0 = P.ffn_conv_w[c], wg1 = P.ffn_conv_w[2 * DFF + c], wg2 = P.ffn_conv_w[4 * DFF + c], bg = P.ffn_conv_b[c];
        const float wv0 = P.ffn_conv_w[DFF + c], wv1 = P.ffn_conv_w[3 * DFF + c], wv2 = P.ffn_conv_w[5 * DFF + c], bv = P.ffn_conv_b[DFF + c];
        const float r0g = bg + wg0 * g254 + wg1 * g255 + wg2 * g0, r1g = bg + wg0 * g255 + wg1 * g0 + wg2 * g1;
        const float r0v = bv + wv0 * v254 + wv1 * v255 + wv2 * v0, r1v = bv + wv0 * v255 + wv1 * v0 + wv2 * v1;
        ACT[(size_t)(256 * pm) * DFF + c] = f2bf(gelu_f(r0g) * r0v); ACT[(size_t)(256 * pm + 1) * DFF + c] = f2bf(gelu_f(r1g) * r1v);
    }
}
__device__ __forceinline__ void p10_final(const Params& P, const float* ss4p, int G, int bid) {
    int tid = threadIdx.x; asm volatile("" : "+v"(tid)); const int lane = tid & 63, gw = bid * 8 + (tid >> 6), NGW = G * 8;
    f32x4 gf[4];
#pragma unroll
    for (int j = 0; j < 4; ++j) gf[j] = *((const f32x4*)P.g_final + 64 * j + lane);
    for (int m = gw; m < T; m += NGW) { const float rs = rstd_from_parts(ss4p, m); f32x4* xr = (f32x4*)(P.out + (size_t)m * DM) + lane;
#pragma unroll
        for (int j = 0; j < 4; ++j) xr[64 * j] = xr[64 * j] * rs * gf[j]; }
}

#define XB_TMO      128
#define XB_XCNT(j)  (256  + 64 * (j))
#define XB_XSUB(j)  (1280 + 64 * (j))
#define XB_XGEN(j)  (2304 + 64 * (j))
#define XB_TOP      3328
#define XB_TOPGEN   3392
#define XCD_BAR_WORDS 3456
#define XB_SPIN_CAP (1u << 18)

__device__ __forceinline__ unsigned xb_ld(unsigned* p)              { return __hip_atomic_load(p, __ATOMIC_RELAXED, __HIP_MEMORY_SCOPE_AGENT); }
__device__ __forceinline__ unsigned xb_add(unsigned* p, unsigned v) { return __hip_atomic_fetch_add(p, v, __ATOMIC_RELAXED, __HIP_MEMORY_SCOPE_AGENT); }
__device__ __forceinline__ unsigned xb_xcc_id() { return (unsigned)__builtin_amdgcn_s_getreg((3 << 11) | 20) & 0xFu; }
#define XB_SPIN(cond, bar) do { unsigned _sp = 0; while (cond) { __builtin_amdgcn_s_sleep(1); \
    if ((++_sp & 255u) == 0u) { if (xb_ld(&(bar)[XB_TMO])) break; if (_sp > XB_SPIN_CAP) { atomicAdd(&(bar)[XB_TMO], 1u); break; } } } } while (0)

struct XcdBarrier {
    unsigned* bar; unsigned x;
    volatile LAS unsigned* st;
};

__device__ __forceinline__ XcdBarrier xcd_barrier_post(unsigned* bar, volatile LAS unsigned* st) {
    XcdBarrier b; b.bar = bar; b.x = xb_xcc_id(); b.st = st;
    if (threadIdx.x == 0) (void)xb_add(&bar[XB_XCNT(b.x)], 1u);
    return b;
}
__device__ __forceinline__ void xcd_barrier_complete(unsigned* bar, unsigned x, unsigned& nloc, unsigned& nx) {
    const unsigned G = gridDim.x * gridDim.y * gridDim.z;
    unsigned sum, cnt, mine, sp = 0u;
    for (;;) {
        sum = 0u; cnt = 0u; mine = 0u;
#pragma unroll
        for (unsigned j = 0; j < 16; ++j) { const unsigned c = xb_ld(&bar[XB_XCNT(j)]); sum += c; cnt += (c > 0u) ? 1u : 0u; mine = (j == x) ? c : mine; }
        if (sum == G) break;
        __builtin_amdgcn_s_sleep(1);
        if ((++sp & 255u) == 0u) { if (xb_ld(&bar[XB_TMO])) break; if (sp > XB_SPIN_CAP) { atomicAdd(&bar[XB_TMO], 1u); break; } }
    }
    nloc = mine > 0u ? mine : 1u; nx = cnt > 0u ? cnt : 1u;
}

__device__ __forceinline__ void xcd_barrier(const XcdBarrier& b) {
    asm volatile("s_waitcnt vmcnt(0)" ::: "memory");
    __syncthreads();
    if (threadIdx.x == 0) {
        unsigned* bar = b.bar;
        __builtin_amdgcn_s_waitcnt(0);
        unsigned nloc = b.st[0], nx = b.st[1];
        if (nloc == 0u) { xcd_barrier_complete(bar, b.x, nloc, nx); b.st[0] = nloc; b.st[1] = nx; }
        const unsigned old = xb_add(&bar[XB_XSUB(b.x)], 1u);
        const unsigned gen = old / nloc;
        if (old + 1u == (gen + 1u) * nloc) {
            __builtin_amdgcn_fence(__ATOMIC_RELEASE, "agent");
            asm volatile("s_waitcnt vmcnt(0)" ::: "memory");
            const unsigned og = xb_add(&bar[XB_TOP], 1u);
            const unsigned tg = og / nx;
            if (og + 1u == (tg + 1u) * nx) xb_add(&bar[XB_TOPGEN], 1u);
            else XB_SPIN(xb_ld(&bar[XB_TOPGEN]) == tg, bar);
            __builtin_amdgcn_fence(__ATOMIC_ACQUIRE, "agent");
            xb_add(&bar[XB_XGEN(b.x)], 1u);
            asm volatile("s_waitcnt vmcnt(0)" ::: "memory");
        } else {
            XB_SPIN(xb_ld(&bar[XB_XGEN(b.x)]) == gen, bar);
            __builtin_amdgcn_fence(__ATOMIC_ACQUIRE, "agent");
            asm volatile("s_waitcnt vmcnt(0)" ::: "memory");
        }
    }
    __syncthreads();
}

__global__ void __launch_bounds__(NTHREADS, 2) mega_fwd(Params P) {
    extern __shared__ __attribute__((aligned(16))) unsigned char lds_raw[];
    LAS unsigned char* lds = (LAS unsigned char*)lds_raw;
    cg::grid_group grid = cg::this_grid();
    const int G = gridDim.x, bid = blockIdx.x;
    unsigned char* ws = P.ws;
    bf16_t* BIG = (bf16_t*)(ws + WS_BIG);
    bf16_t *B0 = BIG, *B1 = BIG + TS, *B2 = BIG + 2 * TS, *B3 = BIG + 3 * TS, *B4 = BIG + 4 * TS, *B5 = BIG + 5 * TS;
    bf16_t* XB = (bf16_t*)(ws + WS_XB);
    float *ss2p = (float*)(ws + WS_SS2P), *ss3p = (float*)(ws + WS_SS3P), *ss4p = (float*)(ws + WS_SS4P);

    volatile LAS unsigned* bst = (volatile LAS unsigned*)(lds + LDS_BYTES - 64);
    if (threadIdx.x < 2) bst[threadIdx.x] = 0u;
    unsigned* barw = (unsigned*)(ws + WS_BAR);
    if (ws == nullptr) grid.sync();
    __syncthreads();
    XcdBarrier xbar = xcd_barrier_post(barw, bst);
    p0_prologue(lds, P, G, bid);
    if (PROBE_ID == 1) { xcd_barrier(xbar); p0_prologue(lds, P, G, bid); }
    if (PROBE_ID == 3) { for (int i = 0; i < 10; ++i) xcd_barrier(xbar); }
    xcd_barrier(xbar);
    {
        pg8::Gemm g{XB, (const bf16_t*)(ws + WS_WIN), T, DIN, DM}; pg8::StaticOrder S; S.init(T, DIN, G, bid);
        EpiZ E{BIG};
        pg8::gemm_phase<EpiZ, pg8::StaticOrder, true, true>(lds, g, S, E);
        if (PROBE_ID == 5) pg8::gemm_phase<EpiZ, pg8::StaticOrder, true, true>(lds, g, S, E);
    }
    xcd_barrier(xbar);
    if (PROBE_ID == 2) { p2_rglru(lds, P, B0, B1, (bf16_t*)P.out, (const bf16_t*)(ws + WS_WRG), nullptr, nullptr, G, bid); }
    if (G == 256) p2_rglru(lds, P, B0, B1, B1, (const bf16_t*)(ws + WS_WRG), B2, B3, G, bid);
    else { p2_rglru(lds, P, B0, B1, B1, (const bf16_t*)(ws + WS_WRG), nullptr, nullptr, G, bid); p2_shortconv(P, B2, B3, G, bid); }
    xcd_barrier(xbar);
    {
        pg8::Gemm g{B1, (const bf16_t*)(ws + WS_WPA), T, DM, DM, B2, (const bf16_t*)(ws + WS_WPB)}; pg8::StaticOrder2 S; S.init(T, DM, G, bid);
        EpiMerge E{B4, B5, B0};
        pg8::gemm_phase<EpiMerge, pg8::StaticOrder2, true, true>(lds, g, S, E);
    }
    xcd_barrier(xbar);
    {
        pg8::Gemm g{B0, (const bf16_t*)(ws + WS_WOUT), T, DM, DM}; pg8::StaticOrder S; S.init(T, DM, G, bid);
        EpiResB<true, true> E{XB, (const float*)(ws + WS_RSTD1), XB, ss2p};
        pg8::gemm_phase<EpiResB<true, true>, pg8::StaticOrder, true, true>(lds, g, S, E);
    }
    xcd_barrier(xbar);
    {
        pg8::Gemm g{XB, (const bf16_t*)(ws + WS_WUP), T, 2 * DFF, DM}; pg8::StaticOrder S; S.init(T, 2 * DFF, G, bid);
        EpiAct E{B0, ss2p, P.ffn_conv_w, P.ffn_conv_b, (float*)B4, (LAS float*)(lds + 131072)};
        pg8::gemm_phase<EpiAct, pg8::StaticOrder, true, true>(lds, g, S, E);
        if (PROBE_ID == 6) pg8::gemm_phase<EpiAct, pg8::StaticOrder, true, true>(lds, g, S, E);
    }
    xcd_barrier(xbar);
    p6_fixup(P, (const float*)B4, B0, G, bid);
    xcd_barrier(xbar);
    {
        pg8::Gemm g{B0, (const bf16_t*)(ws + WS_WDOWN), T, DM, DFF}; pg8::StaticOrder S; S.init(T, DM, G, bid);
        EpiResB<false, false> E{XB, nullptr, B5, nullptr};
        pg8::gemm_phase<EpiResB<false, false>, pg8::StaticOrder, true, true>(lds, g, S, E);
    }
    {
        pg8::Gemm g{(const bf16_t*)(ws + WS_PB), (const bf16_t*)(ws + WS_WPLE), T, DM, DPLE}; pg8::StaticOrder S; S.init(T, DM, G, bid);
        EpiE0 E{B3, ss3p};
        pg8::gemm_phase<EpiE0, pg8::StaticOrder, true, true>(lds, g, S, E);
    }
    xcd_barrier(xbar);
    {
        pg8::Gemm g{B5, (const bf16_t*)(ws + WS_WGATE), T, DM, DM}; pg8::StaticOrder S; S.init(T, DM, G, bid);
        EpiFin E{B5, P.out, B3, ss3p, P.g_ple, P.g_final, ss4p, (unsigned*)(ws + WS_BAR + 16384)};
        pg8::gemm_phase<EpiFin, pg8::StaticOrder, true, true>(lds, g, S, E);
    }
}

extern "C" void kernel_launch(void* const* d_in, const int* in_sizes, int n_in, void* d_out, int out_size, void* d_ws, size_t ws_size, hipStream_t stream) {
    static int grid = 0;
    if (grid == 0) {
        if (n_in != 24 || in_sizes[0] != T * DM || out_size != T * DM || ws_size < WS_END) { fprintf(stderr, "kernel_launch: unexpected shapes (n_in %d, in0 %d, out %d, ws %zu); nothing launched\n", n_in, n_in > 0 ? in_sizes[0] : -1, out_size, ws_size); grid = -1; return; }
        int dev = 0, cus = 0, per_cu = 0;
        if (hipGetDevice(&dev) != hipSuccess || hipDeviceGetAttribute(&cus, hipDeviceAttributeMultiprocessorCount, dev) != hipSuccess) { fprintf(stderr, "kernel_launch: device query failed\n"); grid = -1; return; }
        if (hipFuncSetAttribute((const void*)mega_fwd, hipFuncAttributeMaxDynamicSharedMemorySize, LDS_BYTES) != hipSuccess) { fprintf(stderr, "kernel_launch: hipFuncSetAttribute failed\n"); grid = -1; return; }
        if (hipOccupancyMaxActiveBlocksPerMultiprocessor(&per_cu, (const void*)mega_fwd, NTHREADS, LDS_BYTES) != hipSuccess || per_cu < 1) { fprintf(stderr, "kernel_launch: occupancy query says %d blocks per CU\n", per_cu); grid = -1; return; }
        grid = cus;
    }
    if (grid < 0) return;
    Params p{};
    const float** pp = (const float**)&p;
    for (int i = 0; i < 24; ++i) pp[i] = (const float*)d_in[i];
    p.out = (float*)d_out; p.ws = (unsigned char*)d_ws;
    if (hipMemsetAsync((char*)d_ws + WS_BAR, 0, 65536, stream) != hipSuccess) { fprintf(stderr, "kernel_launch: hipMemsetAsync of the barrier words failed\n"); return; }
    void* args[] = {&p};
    hipError_t e = hipLaunchCooperativeKernel((const void*)mega_fwd, dim3(grid), dim3(NTHREADS), args, LDS_BYTES, stream);
    if (e != hipSuccess) fprintf(stderr, "kernel_launch: cooperative launch failed: %s (grid %d)\n", hipGetErrorString(e), grid);
}
```
